# Optimizing an MI355X kernel written in HIP

```python
import jax
import jax.numpy as jnp
from jax import lax
import numpy as np

D_MODEL = 1024
BATCH = 16
SEQ = 256
DEPTH = 4
DEC_BATCH = 8
DEC_SEQ = 1024
PAST_LEN = 512

GRID_W = 64
N_MIX = 3
N_A = (DEPTH + 2) // 3
N_B = (DEPTH + 1) // 3
N_C = DEPTH // 3
CHUNK = 128
A_HALF = 2 * D_MODEL
A_GROUPS = 8
N_HEADS = 16
HEAD_DIM = D_MODEL // N_HEADS
WIN_ROWS_MAX = 8
WIN_COLS = 16
CONV_W = 3
D_FF = 4 * D_MODEL
EPS = 1e-6

kernel_name = 'hybrid_diffusion_gmlp_natten_shortconv_step'


def rms_norm(x, g):
    xf = x.astype(jnp.float32)
    y = xf * lax.rsqrt(jnp.mean(xf * xf, axis=-1, keepdims=True) + EPS)
    return (y * g.astype(jnp.float32)).astype(x.dtype)


def modulation(cond, w, b):
    m = jax.nn.silu(cond) @ w + b
    return jnp.split(m[:, None, :], 6, axis=-1)


def modulate(h, shift, scale):
    return h * (1 + scale) + shift


def sq_relu_mlp(h, w1, w2):
    return jnp.square(jax.nn.relu(h @ w1)) @ w2


def chunk_gmlp(h, w_in, v_gain, ws, bs, w_out):
    b, l, _ = h.shape
    z = jax.nn.gelu(h @ w_in)
    u, v = jnp.split(z, 2, axis=-1)
    v = rms_norm(v, v_gain).reshape(b, l // CHUNK, CHUNK, A_GROUPS, A_HALF // A_GROUPS)
    s = jnp.einsum('gpq,bnqgc->bnpgc', ws, v) + bs.T[None, None, :, :, None]
    return (u * s.reshape(b, l, A_HALF)) @ w_out


def short_gated_conv(h, w_in, conv_w, conv_b, w_out):
    bg, cg, xt = jnp.split(h @ w_in, 3, axis=-1)
    z = cg * xt
    zc = lax.conv_general_dilated(z, conv_w[:, None, :], window_strides=(1,), padding=((1, 1),),
                                  dimension_numbers=('NWC', 'WIO', 'NWC'),
                                  feature_group_count=D_MODEL) + conv_b
    return (bg * zc) @ w_out


def qkv_heads(h, w_qkv, q_gain, k_gain):
    b, l, _ = h.shape
    qkv = (h @ w_qkv).reshape(b, l, 3, N_HEADS, HEAD_DIM)
    return rms_norm(qkv[:, :, 0], q_gain), rms_norm(qkv[:, :, 1], k_gain), qkv[:, :, 2]


def context_attention(q, k, v):
    b, l, _, _ = q.shape
    s = jnp.einsum('bqhd,bkhd->bhqk', q, k).astype(jnp.float32) * (HEAD_DIM ** -0.5)
    p = jax.nn.softmax(s, axis=-1).astype(v.dtype)
    return jnp.einsum('bhqk,bkhd->bqhd', p, v).reshape(b, l, D_MODEL)


def neighbourhood_attention(q, k, v, ck, cv, rpb):
    b, l, _, _ = q.shape
    rows = l // GRID_W
    wr = min(WIN_ROWS_MAX, rows)
    r = jnp.arange(rows)
    row_idx = jnp.clip(r - wr // 2, 0, rows - wr)[:, None] + jnp.arange(wr)[None, :]
    col = jnp.arange(GRID_W)
    col_start = jnp.clip(col - WIN_COLS // 2, 0, GRID_W - WIN_COLS)
    col_ok = (col[None, :] >= col_start[:, None]) & (col[None, :] < col_start[:, None] + WIN_COLS)
    rel_r = row_idx - r[:, None] + (WIN_ROWS_MAX - 1)
    rel_c = jnp.clip(col[None, :] - col[:, None] + (WIN_COLS - 1), 0, 2 * WIN_COLS - 2)
    bias = rpb[:, rel_r[:, None, :, None], rel_c[None, :, None, :]]
    bias = jnp.moveaxis(bias, 0, 1).astype(jnp.float32)
    qg = q.reshape(b, rows, GRID_W, N_HEADS, HEAD_DIM)
    k_band = k.reshape(b, rows, GRID_W, N_HEADS, HEAD_DIM)[:, row_idx]
    v_band = v.reshape(b, rows, GRID_W, N_HEADS, HEAD_DIM)[:, row_idx]
    scale = HEAD_DIM ** -0.5
    s_loc = jnp.einsum('brqhd,brikhd->brhqik', qg, k_band).astype(jnp.float32) * scale + bias
    s_loc = jnp.where(col_ok[:, None, :], s_loc, -jnp.inf)
    s_ctx = jnp.einsum('brqhd,bkhd->brhqk', qg, ck).astype(jnp.float32) * scale
    n_loc = wr * GRID_W
    s_all = jnp.concatenate([s_loc.reshape(b, rows, N_HEADS, GRID_W, n_loc), s_ctx], axis=-1)
    p = jax.nn.softmax(s_all, axis=-1).astype(v.dtype)
    p_loc = p[..., :n_loc].reshape(b, rows, N_HEADS, GRID_W, wr, GRID_W)
    o = (jnp.einsum('brhqik,brikhd->brqhd', p_loc, v_band)
         + jnp.einsum('brhqk,bkhd->brqhd', p[..., n_loc:], cv))
    return o.reshape(b, l, D_MODEL)


def setup_inputs(seed: int = 0) -> dict:
    key = jax.random.key(seed)
    ks = jax.random.split(key, 26)
    D = D_MODEL

    def nrm(k, shape, scale):
        return jax.random.normal(k, shape, jnp.float32) * scale

    return {
        'x_prompt': nrm(ks[0], (BATCH, SEQ, D), 1.0),
        'x_sample': nrm(ks[1], (DEC_BATCH, DEC_SEQ, D), 1.0),
        'cache_k': nrm(ks[2], (DEC_BATCH, N_B, PAST_LEN, N_HEADS, HEAD_DIM), 1.0),
        'cache_v': nrm(ks[3], (DEC_BATCH, N_B, PAST_LEN, N_HEADS, HEAD_DIM), 1.0),
        'c': nrm(ks[4], (DEC_BATCH, D), 1.0),
        'c_ctx': nrm(ks[5], (D,), 1.0),
        'norm_g': 1.0 + nrm(ks[6], (DEPTH, 2, D), 0.02),
        'ada_w': nrm(ks[7], (DEPTH, D, 6 * D), D ** -0.5),
        'ada_b': nrm(ks[8], (DEPTH, 6 * D), 0.02),
        'a_w_in': nrm(ks[9], (N_A, D, 2 * A_HALF), D ** -0.5),
        'a_v_gain': 1.0 + nrm(ks[10], (N_A, A_HALF), 0.02),
        'a_ws': nrm(ks[11], (N_A, A_GROUPS, CHUNK, CHUNK), CHUNK ** -0.5),
        'a_bs': 1.0 + nrm(ks[12], (N_A, A_GROUPS, CHUNK), 0.02),
        'a_w_out': nrm(ks[13], (N_A, A_HALF, D), A_HALF ** -0.5),
        'b_w_qkv': nrm(ks[14], (N_B, D, 3 * D), D ** -0.5),
        'b_q_gain': 1.0 + nrm(ks[15], (N_B, HEAD_DIM), 0.02),
        'b_k_gain': 1.0 + nrm(ks[16], (N_B, HEAD_DIM), 0.02),
        'b_rpb': nrm(ks[17], (N_B, N_HEADS, 2 * WIN_ROWS_MAX - 1, 2 * WIN_COLS - 1), 0.1),
        'b_w_o': nrm(ks[18], (N_B, D, D), D ** -0.5),
        'c_w_in': nrm(ks[19], (N_C, D, 3 * D), D ** -0.5),
        'c_conv_w': nrm(ks[20], (N_C, CONV_W, D), CONV_W ** -0.5),
        'c_conv_b': nrm(ks[21], (N_C, D), 0.02),
        'c_w_out': nrm(ks[22], (N_C, D, D), D ** -0.5),
        'ff_w1': nrm(ks[23], (DEPTH, D, D_FF), D ** -0.5),
        'ff_w2': nrm(ks[24], (DEPTH, D_FF, D), D_FF ** -0.5),
    }


def reference(x_prompt, x_sample, cache_k, cache_v, c, c_ctx, norm_g, ada_w, ada_b,
              a_w_in, a_v_gain, a_ws, a_bs, a_w_out,
              b_w_qkv, b_q_gain, b_k_gain, b_rpb, b_w_o,
              c_w_in, c_conv_w, c_conv_b, c_w_out, ff_w1, ff_w2):
    xp, xs = x_prompt, x_sample
    cp = jnp.broadcast_to(c_ctx, (xp.shape[0], c_ctx.shape[0]))
    new_k, new_v = [], []
    for i in range(DEPTH):
        kind, j = i % N_MIX, i // N_MIX
        mp = modulation(cp, ada_w[i], ada_b[i])
        ms = modulation(c, ada_w[i], ada_b[i])
        hp = modulate(rms_norm(xp, norm_g[i, 0]), mp[0], mp[1])
        hs = modulate(rms_norm(xs, norm_g[i, 0]), ms[0], ms[1])
        if kind == 0:
            op = chunk_gmlp(hp, a_w_in[j], a_v_gain[j], a_ws[j], a_bs[j], a_w_out[j])
            os_ = chunk_gmlp(hs, a_w_in[j], a_v_gain[j], a_ws[j], a_bs[j], a_w_out[j])
        elif kind == 1:
            qp, kp, vp = qkv_heads(hp, b_w_qkv[j], b_q_gain[j], b_k_gain[j])
            new_k.append(kp)
            new_v.append(vp)
            op = context_attention(qp, kp, vp) @ b_w_o[j]
            qs, ks_, vs = qkv_heads(hs, b_w_qkv[j], b_q_gain[j], b_k_gain[j])
            os_ = neighbourhood_attention(qs, ks_, vs, cache_k[:, j], cache_v[:, j], b_rpb[j]) @ b_w_o[j]
        else:
            op = short_gated_conv(hp, c_w_in[j], c_conv_w[j], c_conv_b[j], c_w_out[j])
            os_ = short_gated_conv(hs, c_w_in[j], c_conv_w[j], c_conv_b[j], c_w_out[j])
        xp = xp + mp[2] * op
        xs = xs + ms[2] * os_
        hp = modulate(rms_norm(xp, norm_g[i, 1]), mp[3], mp[4])
        hs = modulate(rms_norm(xs, norm_g[i, 1]), ms[3], ms[4])
        xp = xp + mp[5] * sq_relu_mlp(hp, ff_w1[i], ff_w2[i])
        xs = xs + ms[5] * sq_relu_mlp(hs, ff_w1[i], ff_w2[i])
    new_cache_k = jnp.stack(new_k, axis=1)
    new_cache_v = jnp.stack(new_v, axis=1)
    return (xp, xs, new_cache_k, new_cache_v)
```

```cpp
#include <hip/hip_runtime.h>
#include <hip/hip_cooperative_groups.h>
#include <cstdio>
#include <cstdint>
namespace cg = cooperative_groups;

namespace pg8 {
#define PG8_LAS __attribute__((address_space(3)))
typedef unsigned short bf16_t;
typedef short bf16x8 __attribute__((ext_vector_type(8)));
typedef float f32x4 __attribute__((ext_vector_type(4)));
typedef unsigned u32x4 __attribute__((ext_vector_type(4)));
constexpr int BM = 256, BK = 64, HALF = 128, HTB = HALF * BK * 2  , STAGE_BYTES = 8 * HTB, NXCD = 8, WGM = 8;

__host__ __device__ __forceinline__ int lds_byte(int r, int c) { const int st = (r >> 4) * 2 + (c >> 5), rr = r & 15, cc = c & 31, ob = rr * 64 + cc * 2; return st * 1024 + (ob ^ (((ob >> 9) & 1) << 5)); }
__host__ __device__ __forceinline__ void stage_rc(int b, int& R, int& C) { const int st = b / 1024, sb = b % 1024, swz = sb ^ (((sb >> 9) & 1) << 5); R = (st >> 1) * 16 + swz / 64; C = (st & 1) * 32 + (swz % 64) / 2; }
__host__ __device__ __forceinline__ int perm32(int rho) { const int n = rho >> 4, i = rho & 15; return 8 * (i >> 2) + 4 * n + (i & 3); }

struct Unit { int pm, pn; };
struct Gemm { const bf16_t* A; const bf16_t* Bt; int M, N, K; };

struct StaticOrder {
    int nM, nN, nwg, G, c;
    __host__ __device__ void init(int M, int N, int G_, int c_) { nM = M / BM; nN = N / BM; nwg = nM * nN; G = G_; c = c_; }
    __host__ __device__ bool next(int i, Unit& u) const {
        const long L = (long)i * G + c; if (L >= nwg) return false;
        int wgid = (int)L; { const int q = nwg / NXCD, r = nwg % NXCD, xcd = wgid % NXCD, off = wgid / NXCD; wgid = (xcd < r ? xcd * (q + 1) : r * (q + 1) + (xcd - r) * q) + off; }
        const int nig = WGM * nN, gid = wgid / nig, fm = gid * WGM, gsz = (nM - fm) < WGM ? (nM - fm) : WGM;
        u.pm = fm + ((wgid % nig) % gsz); u.pn = (wgid % nig) / gsz; return true;
    }
    __device__ __forceinline__ void a_ready(const Unit&) const {}
    __device__ __forceinline__ void done(const Unit&) const {}
};

__device__ __forceinline__ unsigned cvt_pk_bf16(float lo, float hi) { unsigned r; asm volatile("v_cvt_pk_bf16_f32 %0, %1, %2" : "=v"(r) : "v"(lo), "v"(hi)); return r; }

template <class Epi, class Sched, bool ALIGN_EPI = false, bool SP2 = false>
__device__ __forceinline__ void gemm_phase(PG8_LAS unsigned char* lds, const Gemm g, const Sched& S, const Epi& E) {
    const int tid = threadIdx.x, wid = __builtin_amdgcn_readfirstlane(tid >> 6), lane = tid & 63, wr = wid >> 2, wc = wid & 3, fr = lane & 15, fq = lane >> 4;
    const int K = g.K, nt = K / BK;
    unsigned voffA[2], voffB[2];
#pragma unroll
    for (int i = 0; i < 2; ++i) { int R, C; stage_rc(tid * 16 + i * 8192, R, C); const int Rb = Epi::PERM ? ((R & ~31) + perm32(R & 31)) : R;
        voffA[i] = (unsigned)(R * K + C) * 2u; voffB[i] = (unsigned)(Rb * K + C) * 2u; }
    const size_t kstep = (size_t)(BK * 2);
    const size_t hstep = (size_t)HALF * K * 2;
    const size_t tstep = 2 * hstep;
    const unsigned ldsw = (unsigned)wid * 1024u;
    const int aoff = lds_byte(wr * 64 + fr, fq * 8), boff = lds_byte(wc * 32 + fr, fq * 8);
#define PG8_SA(b, h) (((b) * 2 + (h)) * HTB)
#define PG8_SB(b, h) ((4 + (b) * 2 + (h)) * HTB)
#define PG8_STAGE(bufoff, gbase, voff) do { _Pragma("unroll") for (int _i = 0; _i < 2; ++_i) \
        __builtin_amdgcn_global_load_lds((const unsigned*)((const char*)(gbase) + (voff)[_i]), (PG8_LAS unsigned*)(lds + (bufoff) + ldsw + _i * 8192), 16, 0, 0); } while (0)
#define PG8_LDA(dst, b, h) do { _Pragma("unroll") for (int m = 0; m < 4; ++m) _Pragma("unroll") for (int k = 0; k < 2; ++k) dst[m][k] = *(const PG8_LAS bf16x8*)(lds + PG8_SA(b, h) + aoff + m * 2048 + k * 1024); } while (0)
#define PG8_LDB(dst, b, h) do { _Pragma("unroll") for (int n = 0; n < 2; ++n) _Pragma("unroll") for (int k = 0; k < 2; ++k) dst[n][k] = *(const PG8_LAS bf16x8*)(lds + PG8_SB(b, h) + boff + n * 2048 + k * 1024); } while (0)
#define PG8_MMA(ai, bj, At, Bt) do { __builtin_amdgcn_s_setprio(1); _Pragma("unroll") for (int m = 0; m < 4; ++m) _Pragma("unroll") for (int n = 0; n < 2; ++n) _Pragma("unroll") for (int k = 0; k < 2; ++k) \
        acc[ai][bj][m][n] = __builtin_amdgcn_mfma_f32_16x16x32_bf16(Bt[n][k], At[m][k], acc[ai][bj][m][n], 0, 0, 0); __builtin_amdgcn_s_setprio(0); } while (0)
#define PG8_WAIT_V(n) asm volatile("s_waitcnt vmcnt(" #n ")" ::: "memory")
#define PG8_WAIT_L(n) asm volatile("s_waitcnt lgkmcnt(" #n ")" ::: "memory")
#define PG8_BAR __builtin_amdgcn_s_barrier()
#define PG8_SCHED __builtin_amdgcn_sched_barrier(0)
    Unit cur, nxt; int ui = 0;
    if (!S.next(0, cur)) return;
    f32x4 acc[2][2][4][2];
#pragma unroll
    for (int a = 0; a < 2; ++a)
#pragma unroll
        for (int b = 0; b < 2; ++b)
#pragma unroll
            for (int m = 0; m < 4; ++m)
#pragma unroll
                for (int n = 0; n < 2; ++n) acc[a][b][m][n] = (f32x4){0.f, 0.f, 0.f, 0.f};
    bf16x8 At[4][2], B0[2][2], B1[2][2];
    const char* cA = (const char*)g.A + (size_t)cur.pm * tstep; const char* cB = (const char*)g.Bt + (size_t)cur.pn * tstep;
    S.a_ready(cur);
    if constexpr (SP2) {
        PG8_STAGE(PG8_SB(0, 0), cB, voffB); PG8_STAGE(PG8_SB(0, 1), cB + hstep, voffB); PG8_STAGE(PG8_SA(0, 0), cA, voffA); PG8_STAGE(PG8_SA(0, 1), cA + hstep, voffA);
        if (wr == 1) PG8_BAR;
        PG8_WAIT_V(2); PG8_BAR;
        PG8_STAGE(PG8_SB(1, 0), cB + kstep, voffB); PG8_STAGE(PG8_SA(1, 0), cA + kstep, voffA); PG8_STAGE(PG8_SB(1, 1), cB + hstep + kstep, voffB);
        PG8_WAIT_V(6); PG8_BAR;
    } else {
        PG8_STAGE(PG8_SB(0, 0), cB, voffB); PG8_STAGE(PG8_SA(0, 0), cA, voffA); PG8_STAGE(PG8_SB(0, 1), cB + hstep, voffB); PG8_STAGE(PG8_SA(0, 1), cA + hstep, voffA);
        if (wr == 1) PG8_BAR;
        PG8_WAIT_V(4); PG8_BAR;
        PG8_STAGE(PG8_SB(1, 0), cB + kstep, voffB); PG8_STAGE(PG8_SA(1, 0), cA + kstep, voffA); PG8_STAGE(PG8_SB(1, 1), cB + hstep + kstep, voffB);
        PG8_WAIT_V(6); PG8_BAR;
    }
    for (;;) {
        const bool has_next = S.next(ui + 1, nxt);
        const char* nA = has_next ? (const char*)g.A + (size_t)nxt.pm * tstep : cA; const char* nB = has_next ? (const char*)g.Bt + (size_t)nxt.pn * tstep : cB;
        for (int t = 0; t < nt; t += 2) {
            const bool last = (t == nt - 2);
            const char* a1 = cA + (size_t)(t + 1) * kstep;
            const char* a2 = last ? nA : cA + (size_t)(t + 2) * kstep; const char* b2 = last ? nB : cB + (size_t)(t + 2) * kstep;
            const char* a3 = a2 + kstep; const char* b3 = b2 + kstep;
            if (last && has_next) S.a_ready(nxt);
            if constexpr (SP2) {
            PG8_LDB(B0, 0, 0); PG8_LDB(B1, 0, 1); PG8_SCHED; PG8_LDA(At, 0, 0); PG8_STAGE(PG8_SA(1, 1), a1 + hstep, voffA);
            PG8_WAIT_V(8); PG8_WAIT_L(0); PG8_BAR; PG8_MMA(0, 0, At, B0); PG8_MMA(0, 1, At, B1); PG8_BAR; PG8_SCHED;
            PG8_LDA(At, 0, 1); PG8_STAGE(PG8_SB(0, 0), b2, voffB); PG8_STAGE(PG8_SB(0, 1), b2 + hstep, voffB); PG8_STAGE(PG8_SA(0, 0), a2, voffA);
            PG8_WAIT_V(8); PG8_WAIT_L(0); PG8_BAR; PG8_MMA(1, 0, At, B0); PG8_MMA(1, 1, At, B1); PG8_BAR; PG8_SCHED;
            PG8_LDB(B0, 1, 0); PG8_LDB(B1, 1, 1); PG8_SCHED; PG8_LDA(At, 1, 0); PG8_STAGE(PG8_SA(0, 1), a2 + hstep, voffA);
            PG8_WAIT_V(8); PG8_WAIT_L(0); PG8_BAR; PG8_MMA(0, 0, At, B0); PG8_MMA(0, 1, At, B1); PG8_BAR; PG8_SCHED;
            PG8_LDA(At, 1, 1); PG8_STAGE(PG8_SB(1, 0), b3, voffB); PG8_STAGE(PG8_SB(1, 1), b3 + hstep, voffB); PG8_STAGE(PG8_SA(1, 0), a3, voffA);
            PG8_WAIT_V(8); PG8_WAIT_L(0); PG8_BAR; PG8_MMA(1, 0, At, B0); PG8_MMA(1, 1, At, B1); PG8_BAR; PG8_SCHED;
            } else {
            PG8_LDB(B0, 0, 0); PG8_SCHED; PG8_LDA(At, 0, 0); PG8_STAGE(PG8_SA(1, 1), a1 + hstep, voffA);
            PG8_WAIT_L(8); PG8_BAR; PG8_WAIT_L(0); PG8_MMA(0, 0, At, B0); PG8_BAR; PG8_SCHED;
            PG8_LDB(B1, 0, 1); PG8_STAGE(PG8_SB(0, 0), b2, voffB);
            PG8_BAR; PG8_WAIT_L(0); PG8_MMA(0, 1, At, B1); PG8_BAR;
            PG8_LDA(At, 0, 1); PG8_STAGE(PG8_SA(0, 0), a2, voffA);
            PG8_BAR; PG8_WAIT_L(0); PG8_MMA(1, 0, At, B0); PG8_BAR; PG8_SCHED;
            PG8_STAGE(PG8_SB(0, 1), b2 + hstep, voffB);
            PG8_WAIT_V(6); PG8_BAR; PG8_MMA(1, 1, At, B1); PG8_BAR;
            PG8_LDB(B0, 1, 0); PG8_SCHED; PG8_LDA(At, 1, 0); PG8_STAGE(PG8_SA(0, 1), a2 + hstep, voffA);
            PG8_WAIT_L(8); PG8_BAR; PG8_WAIT_L(0); PG8_MMA(0, 0, At, B0); PG8_BAR; PG8_SCHED;
            PG8_LDB(B1, 1, 1); PG8_STAGE(PG8_SB(1, 0), b3, voffB);
            PG8_BAR; PG8_WAIT_L(0); PG8_MMA(0, 1, At, B1); PG8_BAR;
            PG8_LDA(At, 1, 1); PG8_STAGE(PG8_SA(1, 0), a3, voffA);
            PG8_BAR; PG8_WAIT_L(0); PG8_MMA(1, 0, At, B0); PG8_BAR; PG8_SCHED;
            PG8_STAGE(PG8_SB(1, 1), b3 + hstep, voffB);
            PG8_WAIT_V(6); PG8_BAR; PG8_MMA(1, 1, At, B1); PG8_BAR;
            }
        }
        if constexpr (ALIGN_EPI) { if (wr == 0) PG8_BAR; }
        if constexpr (!Epi::AFTER_DRAIN) { E(acc, cur, wr, wc, fr, fq); S.done(cur); }
        if (!has_next) break;
#pragma unroll
        for (int a = 0; a < 2; ++a)
#pragma unroll
            for (int b = 0; b < 2; ++b)
#pragma unroll
                for (int m = 0; m < 4; ++m)
#pragma unroll
                    for (int n = 0; n < 2; ++n) acc[a][b][m][n] = (f32x4){0.f, 0.f, 0.f, 0.f};
        cur = nxt; cA = nA; cB = nB; ++ui;
        if constexpr (ALIGN_EPI) { if (wr == 1) PG8_BAR; }
    }
    PG8_WAIT_V(0);
    if constexpr (!ALIGN_EPI) { if (wr == 0) PG8_BAR; }
    PG8_BAR;
    if constexpr (Epi::AFTER_DRAIN) { E.fused(acc, cur, wr, wc, fr, fq, lds, wid, lane); S.done(cur); }
#undef PG8_SA
#undef PG8_SB
#undef PG8_STAGE
#undef PG8_LDA
#undef PG8_LDB
#undef PG8_MMA
#undef PG8_WAIT_V
#undef PG8_WAIT_L
#undef PG8_BAR
#undef PG8_SCHED
}
}
#define LAS __attribute__((address_space(3)))
typedef unsigned short bf16;
typedef float f32x4 __attribute__((ext_vector_type(4)));
typedef float f32x2 __attribute__((ext_vector_type(2)));
typedef float f32x16 __attribute__((ext_vector_type(16)));
typedef short bf16x8 __attribute__((ext_vector_type(8)));
typedef short s16x4 __attribute__((ext_vector_type(4)));
typedef unsigned u32x4 __attribute__((ext_vector_type(4)));
typedef unsigned u32x2 __attribute__((ext_vector_type(2)));

constexpr int D = 1024, TP = 4096, TS = 8192, T = 12288, FF = 4096, AH = 2048, NCOND = 9, MODW = 6144;
constexpr float EPS = 1e-6f, LOG2E = 1.4426950408889634f;
constexpr size_t MiB = 1u << 20;
constexpr size_t WS_CTL = 0, WS_MOD = 1 * MiB, WS_PART = 2 * MiB;
constexpr size_t WS_WA_IN = 4 * MiB, WS_WA_OUT = 20 * MiB, WS_WB_QKV = 28 * MiB, WS_WB_O = 34 * MiB, WS_WC_IN = 36 * MiB, WS_WC_OUT = 42 * MiB;
constexpr size_t WS_WF1 = 44 * MiB, WS_WF2 = 76 * MiB, WS_CKB = 108 * MiB, WS_CVT = 116 * MiB, WS_H = 124 * MiB, WS_BUF1 = 148 * MiB, WS_BUF2 = 244 * MiB, WS_END = 292 * MiB;
constexpr int LDS_BYTES = 147456;
constexpr int NPHASE = 29;

using pg8::cvt_pk_bf16;
__device__ __forceinline__ float bf2f(unsigned short b) { return __uint_as_float((unsigned)b << 16); }
__device__ __forceinline__ float gelu_tanh(float x) {
    const float t = x * x, w = x * (0.7978845608f + 0.0356774081f * t);
    const float e = __builtin_amdgcn_exp2f(-2.885390082f * w);
    return x * __builtin_amdgcn_rcpf(1.0f + e);
}
__device__ __forceinline__ int cond_of_tile(int pm) { return pm < 16 ? 8 : ((pm - 16) >> 2); }
__device__ __forceinline__ int cond_of_row(int m) { return m < TP ? 8 : ((m - TP) >> 10); }

typedef pg8::f32x4 af4;
#define ACC_T const pg8::f32x4 (&acc)[2][2][4][2]
template <int ACT> struct EpiAct {
    static constexpr bool PERM = true, AFTER_DRAIN = false;
    bf16* O; int ldc;
    __device__ __forceinline__ void operator()(ACC_T, const pg8::Unit& u, int wr, int wc, int fr, int fq) const {
        const int row0 = u.pm * 256 + wr * 64 + fr, col0 = u.pn * 256 + wc * 32 + 8 * fq;
#pragma unroll
        for (int ai = 0; ai < 2; ++ai)
#pragma unroll
            for (int m = 0; m < 4; ++m) { bf16* rowp = O + (size_t)(row0 + ai * 128 + m * 16) * ldc + col0;
#pragma unroll
                for (int bj = 0; bj < 2; ++bj) { af4 v0 = acc[ai][bj][m][0], v1 = acc[ai][bj][m][1];
                    if (ACT == 1) {
#pragma unroll
                        for (int i = 0; i < 4; ++i) { v0[i] = gelu_tanh(v0[i]); v1[i] = gelu_tanh(v1[i]); } }
                    if (ACT == 2) {
#pragma unroll
                        for (int i = 0; i < 4; ++i) { float a = fmaxf(v0[i], 0.f), b = fmaxf(v1[i], 0.f); v0[i] = a * a; v1[i] = b * b; } }
                    u32x4 w; w.x = cvt_pk_bf16(v0[0], v0[1]); w.y = cvt_pk_bf16(v0[2], v0[3]); w.z = cvt_pk_bf16(v1[0], v1[1]); w.w = cvt_pk_bf16(v1[2], v1[3]);
                    *(u32x4*)(rowp + bj * 128) = w; } }
    }
};
struct EpiVT {
    static constexpr bool PERM = true, AFTER_DRAIN = false;
    bf16* O; float* part;
    __device__ __forceinline__ void operator()(ACC_T, const pg8::Unit& u, int wr, int wc, int fr, int fq) const {
        const int row0 = u.pm * 256 + wr * 64 + fr, col0 = u.pn * 256 + wc * 32 + 8 * fq;
        float cs[2][2][4];
#pragma unroll
        for (int bj = 0; bj < 2; ++bj)
#pragma unroll
            for (int n = 0; n < 2; ++n)
#pragma unroll
                for (int i = 0; i < 4; ++i) cs[bj][n][i] = 0.f;
#pragma unroll
        for (int ai = 0; ai < 2; ++ai)
#pragma unroll
            for (int m = 0; m < 4; ++m) { bf16* rowp = O + (size_t)(row0 + ai * 128 + m * 16) * T + col0;
#pragma unroll
                for (int bj = 0; bj < 2; ++bj) { af4 v0 = acc[ai][bj][m][0], v1 = acc[ai][bj][m][1];
#pragma unroll
                    for (int i = 0; i < 4; ++i) { v0[i] = gelu_tanh(v0[i]); v1[i] = gelu_tanh(v1[i]); cs[bj][0][i] += v0[i] * v0[i]; cs[bj][1][i] += v1[i] * v1[i]; }
                    u32x4 w; w.x = cvt_pk_bf16(v0[0], v0[1]); w.y = cvt_pk_bf16(v0[2], v0[3]); w.z = cvt_pk_bf16(v1[0], v1[1]); w.w = cvt_pk_bf16(v1[2], v1[3]);
                    *(u32x4*)(rowp + bj * 128) = w; }
                asm volatile("" : "+v"(cs[0][0][0]), "+v"(cs[0][0][1]), "+v"(cs[0][0][2]), "+v"(cs[0][0][3]), "+v"(cs[0][1][0]), "+v"(cs[0][1][1]), "+v"(cs[0][1][2]), "+v"(cs[0][1][3]),
                             "+v"(cs[1][0][0]), "+v"(cs[1][0][1]), "+v"(cs[1][0][2]), "+v"(cs[1][0][3]), "+v"(cs[1][1][0]), "+v"(cs[1][1][1]), "+v"(cs[1][1][2]), "+v"(cs[1][1][3])); }
#pragma unroll
        for (int bj = 0; bj < 2; ++bj)
#pragma unroll
            for (int n = 0; n < 2; ++n)
#pragma unroll
                for (int i = 0; i < 4; ++i) { float s = cs[bj][n][i]; s += __shfl_xor(s, 1); s += __shfl_xor(s, 2); s += __shfl_xor(s, 4); s += __shfl_xor(s, 8);
                    if (fr == 0) part[(size_t)(col0 + bj * 128 + 4 * n + i) * 16 + u.pm * 2 + wr] = s; }
    }
};
struct EpiRes {
    static constexpr bool PERM = true, AFTER_DRAIN = false;
    float* x; const float* gate;
    __device__ __forceinline__ void operator()(ACC_T, const pg8::Unit& u, int wr, int wc, int fr, int fq) const {
        const int row0 = u.pm * 256 + wr * 64 + fr, col0 = u.pn * 256 + wc * 32 + 8 * fq;
        const float* gp = gate + (size_t)cond_of_tile(u.pm) * MODW + col0;
        f32x4 g[2][2];
#pragma unroll
        for (int bj = 0; bj < 2; ++bj) { g[bj][0] = *(const f32x4*)(gp + bj * 128); g[bj][1] = *(const f32x4*)(gp + bj * 128 + 4); }
#pragma unroll
        for (int ai = 0; ai < 2; ++ai)
#pragma unroll
            for (int m = 0; m < 4; ++m) { float* rowp = x + (size_t)(row0 + ai * 128 + m * 16) * D + col0;
#pragma unroll
                for (int bj = 0; bj < 2; ++bj) { f32x4 x0 = *(const f32x4*)(rowp + bj * 128), x1 = *(const f32x4*)(rowp + bj * 128 + 4);
                    x0 += g[bj][0] * acc[ai][bj][m][0]; x1 += g[bj][1] * acc[ai][bj][m][1];
                    *(f32x4*)(rowp + bj * 128) = x0; *(f32x4*)(rowp + bj * 128 + 4) = x1; } }
    }
};
struct EpiQK {
    static constexpr bool PERM = true, AFTER_DRAIN = false;
    bf16* q; bf16* k; const float* qg; const float* kg; float* nck;
    __device__ __forceinline__ void operator()(ACC_T, const pg8::Unit& u, int wr, int wc, int fr, int fq) const {
        const bool isq = u.pn < 4; const int head = 4 * (u.pn & 3) + wc;
        bf16* dst = isq ? q : k; const float* gn = isq ? qg : kg; const float osc = isq ? 0.125f * LOG2E : 1.0f;
        f32x4 g[2][2];
#pragma unroll
        for (int bj = 0; bj < 2; ++bj) { g[bj][0] = *(const f32x4*)(gn + 32 * bj + 8 * fq); g[bj][1] = *(const f32x4*)(gn + 32 * bj + 8 * fq + 4); }
        const int row0 = u.pm * 256 + wr * 64 + fr, col0 = head * 64 + 8 * fq;
#pragma unroll
        for (int ai = 0; ai < 2; ++ai)
#pragma unroll
            for (int m = 0; m < 4; ++m) { const int row = row0 + ai * 128 + m * 16;
                float ss = 0.f;
#pragma unroll
                for (int bj = 0; bj < 2; ++bj)
#pragma unroll
                    for (int n = 0; n < 2; ++n) { const af4 v = acc[ai][bj][m][n]; ss += (v[0] * v[0] + v[1] * v[1]) + (v[2] * v[2] + v[3] * v[3]); }
                ss += __shfl_xor(ss, 16); ss += __shfl_xor(ss, 32);
                const float rstd = __builtin_amdgcn_rsqf(ss * (1.0f / 64.0f) + EPS);
#pragma unroll
                for (int bj = 0; bj < 2; ++bj) { f32x4 v0 = acc[ai][bj][m][0] * rstd * g[bj][0], v1 = acc[ai][bj][m][1] * rstd * g[bj][1];
                    v0 *= osc; v1 *= osc;
                    u32x4 w; w.x = cvt_pk_bf16(v0[0], v0[1]); w.y = cvt_pk_bf16(v0[2], v0[3]); w.z = cvt_pk_bf16(v1[0], v1[1]); w.w = cvt_pk_bf16(v1[2], v1[3]);
                    *(u32x4*)(dst + (size_t)row * D + col0 + 32 * bj) = w; } }
    }
};
struct EpiVTattn {
    static constexpr bool PERM = true, AFTER_DRAIN = false;
    bf16* O; float* ncv;
    __device__ __forceinline__ void operator()(ACC_T, const pg8::Unit& u, int wr, int wc, int fr, int fq) const {
        const int row0 = u.pm * 256 + wr * 64 + fr, col0 = u.pn * 256 + wc * 32 + 8 * fq;
#pragma unroll
        for (int ai = 0; ai < 2; ++ai)
#pragma unroll
            for (int m = 0; m < 4; ++m) { const int row = row0 + ai * 128 + m * 16; bf16* rowp = O + (size_t)row * T + col0;
#pragma unroll
                for (int bj = 0; bj < 2; ++bj) { const af4 v0 = acc[ai][bj][m][0], v1 = acc[ai][bj][m][1];
                    u32x4 w; w.x = cvt_pk_bf16(v0[0], v0[1]); w.y = cvt_pk_bf16(v0[2], v0[3]); w.z = cvt_pk_bf16(v1[0], v1[1]); w.w = cvt_pk_bf16(v1[2], v1[3]);
                    *(u32x4*)(rowp + bj * 128) = w; } }
    }
};
struct EpiConvIn {
    static constexpr bool PERM = true, AFTER_DRAIN = false;
    bf16* bg; bf16* z;
    __device__ __forceinline__ void operator()(ACC_T, const pg8::Unit& u, int wr, int wc, int fr, int fq) const {
        const int row0 = u.pm * 256 + wr * 64 + fr;
#pragma unroll
        for (int ai = 0; ai < 2; ++ai)
#pragma unroll
            for (int m = 0; m < 4; ++m) { const size_t row = (size_t)(row0 + ai * 128 + m * 16);
                if (u.pn < 4) {
#pragma unroll
                    for (int bj = 0; bj < 2; ++bj) { const af4 v0 = acc[ai][bj][m][0], v1 = acc[ai][bj][m][1];
                        u32x4 w; w.x = cvt_pk_bf16(v0[0], v0[1]); w.y = cvt_pk_bf16(v0[2], v0[3]); w.z = cvt_pk_bf16(v1[0], v1[1]); w.w = cvt_pk_bf16(v1[2], v1[3]);
                        *(u32x4*)(bg + row * D + u.pn * 256 + bj * 128 + wc * 32 + 8 * fq) = w; }
                } else {
                    const af4 v0 = acc[ai][0][m][0] * acc[ai][1][m][0], v1 = acc[ai][0][m][1] * acc[ai][1][m][1];
                    u32x4 w; w.x = cvt_pk_bf16(v0[0], v0[1]); w.y = cvt_pk_bf16(v0[2], v0[3]); w.z = cvt_pk_bf16(v1[0], v1[1]); w.w = cvt_pk_bf16(v1[2], v1[3]);
                    *(u32x4*)(z + row * D + (u.pn - 4) * 128 + wc * 32 + 8 * fq) = w; } }
    }
};
struct Args { const float* in[25]; float* out; unsigned char* ws; int ph_lo, ph_hi; };
enum { I_XP = 0, I_XS, I_CK, I_CV, I_C, I_CCTX, I_NORMG, I_ADAW, I_ADAB, I_AWIN, I_AVG, I_AWS, I_ABS, I_AWOUT, I_BWQKV, I_BQG, I_BKG, I_RPB, I_BWO, I_CWIN, I_CCW, I_CCB, I_CWOUT, I_FW1, I_FW2 };

#define LDS_WAIT() asm volatile("s_waitcnt lgkmcnt(0)" ::: "memory")
__device__ __forceinline__ float wave_sum(float v) {
#pragma unroll
    for (int o = 1; o < 64; o <<= 1) v += __shfl_xor(v, o);
    return v;
}
__device__ __forceinline__ int rowmap(int mode, int n) {
    if (mode == 1) { if (n >= 2048) return n; const int sect = n >> 10, hh = (n & 1023) >> 6, d = n & 63; return 256 * (sect * 4 + (hh >> 2)) + 128 * (d >> 5) + 32 * (hh & 3) + (d & 31); }
    if (mode == 2) { if (n < 1024) return n; const int s = (n >= 2048), ch = n - 1024 - 1024 * s; return 1024 + 256 * (ch >> 7) + 128 * s + (ch & 127); }
    return n;
}
__device__ __forceinline__ void transpose_item(const float* W, int K, int N, bf16* WT, int mode, LAS float* scr, int item, int lane) {
    const int nblk = N / 32, kb = item / nblk, nb = item % nblk, k0 = 64 * kb, n0 = 32 * nb;
#pragma unroll 8
    for (int i = 0; i < 32; ++i) { const int kk = 2 * i + (lane >> 5); scr[kk * 33 + (lane & 31)] = W[(size_t)(k0 + kk) * N + n0 + (lane & 31)]; }
    LDS_WAIT(); asm volatile("" ::: "memory");
    const int c = lane & 7; const int r0 = rowmap(mode, n0);
#pragma unroll
    for (int j = 0; j < 4; ++j) { const int n = (lane >> 3) + 8 * j; const LAS float* s = scr + (8 * c) * 33 + n;
        u32x4 o; o.x = cvt_pk_bf16(s[0 * 33], s[1 * 33]); o.y = cvt_pk_bf16(s[2 * 33], s[3 * 33]); o.z = cvt_pk_bf16(s[4 * 33], s[5 * 33]); o.w = cvt_pk_bf16(s[6 * 33], s[7 * 33]);
        *(u32x4*)(WT + (size_t)(r0 + n) * K + k0 + 8 * c) = o; }
    LDS_WAIT(); asm volatile("" ::: "memory");
}
__device__ __forceinline__ void p0_prologue(const Args& a, LAS unsigned char* lds, int tid, int lane, int wave, int G) {
    unsigned char* ws = a.ws;
    if ((int)blockIdx.x < 192) {
        LAS float* sc = (LAS float*)lds;
        LAS float* red = (LAS float*)(lds + 40960);
        for (int e = tid; e < NCOND * D; e += 512) { const int c = e >> 10, k = e & 1023; const float v = (c < 8) ? a.in[I_C][c * D + k] : a.in[I_CCTX][k]; sc[e] = v * __builtin_amdgcn_rcpf(1.0f + __builtin_amdgcn_exp2f(-LOG2E * v)); }
        __syncthreads();
        const int item = blockIdx.x, l = item / 48, n0 = (item % 48) * 128;
        const float* W = a.in[I_ADAW] + (size_t)l * D * MODW + n0 + 2 * lane;
        float acc0[NCOND], acc1[NCOND];
#pragma unroll
        for (int c = 0; c < NCOND; ++c) { acc0[c] = 0.f; acc1[c] = 0.f; }
        const int kbeg = wave * 128;
#pragma unroll 2
        for (int k = kbeg; k < kbeg + 128; k += 4) {
            const f32x2 w0 = *(const f32x2*)(W + (size_t)k * MODW), w1 = *(const f32x2*)(W + (size_t)(k + 1) * MODW), w2 = *(const f32x2*)(W + (size_t)(k + 2) * MODW), w3 = *(const f32x2*)(W + (size_t)(k + 3) * MODW);
#pragma unroll
            for (int c = 0; c < NCOND; ++c) { const f32x4 s = *(const LAS f32x4*)(sc + c * D + k);
                acc0[c] += s[0] * w0[0] + s[1] * w1[0] + s[2] * w2[0] + s[3] * w3[0]; acc1[c] += s[0] * w0[1] + s[1] * w1[1] + s[2] * w2[1] + s[3] * w3[1]; }
        }
#pragma unroll
        for (int c = 0; c < NCOND; ++c) { *(LAS f32x2*)(red + (wave * NCOND + c) * 128 + 2 * lane) = (f32x2){acc0[c], acc1[c]}; }
        __syncthreads();
        float* mod = (float*)(ws + WS_MOD);
        for (int e = tid; e < NCOND * 128; e += 512) { const int c = e >> 7, n = e & 127; float s = a.in[I_ADAB][l * MODW + n0 + n];
#pragma unroll
            for (int w = 0; w < 8; ++w) s += red[(w * NCOND + c) * 128 + n];
            mod[(size_t)(l * NCOND + c) * MODW + n0 + n] = s; }
        __syncthreads();
    }
    LAS float* scr = (LAS float*)(lds + wave * 16384);
    const int gw = blockIdx.x * 8 + wave, NGW = G * 8;
    constexpr int NIT = 28672;
    for (int it = gw; it < NIT; it += NGW) {
        int r = it;
#define TR(cnt, W, K, N, WT, mode) if (r < (cnt)) { transpose_item((W), (K), (N), (WT), (mode), scr, r, lane); continue; } r -= (cnt);
        TR(2048, a.in[I_AWIN], D, 4096, (bf16*)(ws + WS_WA_IN), 0)
        TR(2048, a.in[I_AWIN] + (size_t)D * 4096, D, 4096, (bf16*)(ws + WS_WA_IN + 8 * MiB), 0)
        TR(1024, a.in[I_AWOUT], AH, D, (bf16*)(ws + WS_WA_OUT), 0)
        TR(1024, a.in[I_AWOUT] + (size_t)AH * D, AH, D, (bf16*)(ws + WS_WA_OUT + 4 * MiB), 0)
        TR(1536, a.in[I_BWQKV], D, 3072, (bf16*)(ws + WS_WB_QKV), 1)
        TR(512, a.in[I_BWO], D, D, (bf16*)(ws + WS_WB_O), 0)
        TR(1536, a.in[I_CWIN], D, 3072, (bf16*)(ws + WS_WC_IN), 2)
        TR(512, a.in[I_CWOUT], D, D, (bf16*)(ws + WS_WC_OUT), 0)
        { const int l = r >> 11; if (l < 4) { transpose_item(a.in[I_FW1] + (size_t)l * D * FF, D, FF, (bf16*)(ws + WS_WF1 + (size_t)l * 8 * MiB), 0, scr, r & 2047, lane); continue; } r -= 8192; }
        { const int l = r >> 11; if (l < 4) { transpose_item(a.in[I_FW2] + (size_t)l * D * FF, FF, D, (bf16*)(ws + WS_WF2 + (size_t)l * 8 * MiB), 0, scr, r & 2047, lane); continue; } r -= 8192; }
        { const int b = r >> 8; transpose_item(a.in[I_CV] + (size_t)b * 512 * D, 512, D, (bf16*)(ws + WS_CVT) + (size_t)b * D * 512, 0, scr, r & 255, lane); }
#undef TR
    }
    { const f32x4* src = (const f32x4*)a.in[I_CK]; u32x4* dst = (u32x4*)(ws + WS_CKB);
      for (int e = blockIdx.x * 512 + tid; e < 8 * 512 * D / 8; e += G * 512) { const f32x4 v0 = src[2 * e], v1 = src[2 * e + 1];
          u32x4 w; w.x = cvt_pk_bf16(v0[0], v0[1]); w.y = cvt_pk_bf16(v0[2], v0[3]); w.z = cvt_pk_bf16(v1[0], v1[1]); w.w = cvt_pk_bf16(v1[2], v1[3]); dst[e] = w; } }
}
__device__ __forceinline__ void norm_phase(const Args& a, int l, int which, bool first, int lane, int wave, int G) {
    const float* g = a.in[I_NORMG] + (size_t)(l * 2 + which) * D;
    const float* mod = (const float*)(a.ws + WS_MOD) + (size_t)l * NCOND * MODW + which * 3 * D;
    bf16* H = (bf16*)(a.ws + WS_H);
    f32x4 gv[4];
#pragma unroll
    for (int j = 0; j < 4; ++j) gv[j] = *((const f32x4*)g + lane + 64 * j);
    for (int m = blockIdx.x * 8 + wave; m < T; m += G * 8) {
        const float* xr = first ? (m < TP ? a.in[I_XP] + (size_t)m * D : a.in[I_XS] + (size_t)(m - TP) * D) : a.out + (size_t)m * D;
        const float* mp = mod + (size_t)cond_of_row(m) * MODW;
        f32x4 v[4]; float s = 0.f;
#pragma unroll
        for (int j = 0; j < 4; ++j) { v[j] = *((const f32x4*)xr + lane + 64 * j); s += (v[j][0] * v[j][0] + v[j][1] * v[j][1]) + (v[j][2] * v[j][2] + v[j][3] * v[j][3]); }
        if (first) {
#pragma unroll
            for (int j = 0; j < 4; ++j) *((f32x4*)(a.out + (size_t)m * D) + lane + 64 * j) = v[j]; }
        const float rstd = __builtin_amdgcn_rsqf(wave_sum(s) * (1.0f / D) + EPS);
        u32x2* o8 = (u32x2*)(H + (size_t)m * D) + lane;
#pragma unroll
        for (int j = 0; j < 4; ++j) { const f32x4 sh = *((const f32x4*)mp + lane + 64 * j), scl = *((const f32x4*)(mp + D) + lane + 64 * j);
            const f32x4 y = (v[j] * rstd * gv[j]) * (scl + 1.0f) + sh;
            u32x2 w; w.x = cvt_pk_bf16(y[0], y[1]); w.y = cvt_pk_bf16(y[2], y[3]); o8[64 * j] = w; }
    }
}
#define MFMA32(a, b, c) __builtin_amdgcn_mfma_f32_32x32x16_bf16((a), (b), (c), 0, 0, 0)
__device__ __forceinline__ void gating_phase(const Args& a, int j, LAS unsigned char* lds, int tid, int lane, int wave, int G) {
    const bf16* U = (const bf16*)(a.ws + WS_BUF1); const bf16* VT = U + (size_t)T * AH; bf16* Aout = (bf16*)(a.ws + WS_BUF2);
    const float* part = (const float*)(a.ws + WS_PART);
    const float* wsm = a.in[I_AWS] + (size_t)j * 8 * 128 * 128; const float* bsm = a.in[I_ABS] + (size_t)j * 8 * 128; const float* gain = a.in[I_AVG] + (size_t)j * AH;
    LAS unsigned char* Al = lds;
    LAS float* rq = (LAS float*)(lds + 36864);
    LAS float* bsl = (LAS float*)(lds + 36864 + 512);
    const int l31 = lane & 31, hf = lane >> 5;
    for (int unit = blockIdx.x; unit < 768; unit += G) {
        const int chunk = unit >> 3, g = unit & 7, t0 = chunk * 128;
        if (tid < 128) { const f32x4* pp = (const f32x4*)(part + (size_t)(t0 + tid) * 16); const f32x4 p0 = pp[0], p1 = pp[1], p2 = pp[2], p3 = pp[3];
            const float s = ((p0[0] + p0[1]) + (p0[2] + p0[3])) + ((p1[0] + p1[1]) + (p1[2] + p1[3])) + ((p2[0] + p2[1]) + (p2[2] + p2[3])) + ((p3[0] + p3[1]) + (p3[2] + p3[3]));
            rq[tid] = __builtin_amdgcn_rsqf(s * (1.0f / AH) + EPS); bsl[tid] = bsm[g * 128 + tid]; }
        __syncthreads();
        { const int p = tid >> 2, q0 = (tid & 3) * 32; const float* src = wsm + ((size_t)g * 128 + p) * 128 + q0;
#pragma unroll
          for (int c = 0; c < 4; ++c) { const f32x4 w0 = *(const f32x4*)(src + 8 * c), w1 = *(const f32x4*)(src + 8 * c + 4); const f32x4 r0 = *(const LAS f32x4*)(rq + q0 + 8 * c), r1 = *(const LAS f32x4*)(rq + q0 + 8 * c + 4);
              u32x4 w; w.x = cvt_pk_bf16(w0[0] * r0[0], w0[1] * r0[1]); w.y = cvt_pk_bf16(w0[2] * r0[2], w0[3] * r0[3]); w.z = cvt_pk_bf16(w1[0] * r1[0], w1[1] * r1[1]); w.w = cvt_pk_bf16(w1[2] * r1[2], w1[3] * r1[3]);
              *(LAS u32x4*)(Al + p * 272 + (q0 + 8 * c) * 2) = w; } }
        __syncthreads();
        const int ch = g * 256 + wave * 32 + l31;
        const bf16* vp = VT + (size_t)ch * T + t0 + 8 * hf;
        bf16x8 bfr[8];
#pragma unroll
        for (int ks = 0; ks < 8; ++ks) bfr[ks] = *(const bf16x8*)(vp + 16 * ks);
        f32x16 acc[4];
#pragma unroll
        for (int mt = 0; mt < 4; ++mt) {
#pragma unroll
            for (int i = 0; i < 16; ++i) acc[mt][i] = 0.f;
#pragma unroll
            for (int ks = 0; ks < 8; ++ks) { const bf16x8 af = *(const LAS bf16x8*)(Al + (32 * mt + l31) * 272 + (16 * ks + 8 * hf) * 2); acc[mt] = MFMA32(af, bfr[ks], acc[mt]); }
        }
        const float gn = gain[ch];
#pragma unroll
        for (int mt = 0; mt < 4; ++mt)
#pragma unroll
            for (int i = 0; i < 16; ++i) { const int p = 32 * mt + 8 * (i >> 2) + 4 * hf + (i & 3); const size_t off = (size_t)(t0 + p) * AH + ch;
                const float s = acc[mt][i] * gn + bsl[p]; const float uu = bf2f(U[off]);
                Aout[off] = (bf16)(cvt_pk_bf16(uu * s, 0.f) & 0xffffu); }
        __syncthreads();
    }
}
__device__ __forceinline__ void conv_phase(const Args& a, int j, int lane, int wave, int G) {
    const bf16* BG = (const bf16*)(a.ws + WS_BUF1); const bf16* Z = BG + (size_t)T * D; bf16* A2 = (bf16*)(a.ws + WS_BUF2);
    const float* cw = a.in[I_CCW] + (size_t)j * 3 * D; const float* cb = a.in[I_CCB] + (size_t)j * D;
    for (int m = blockIdx.x * 8 + wave; m < T; m += G * 8) {
        const int tpos = m < TP ? (m & 255) : ((m - TP) & 1023), L = m < TP ? 256 : 1024;
        const bool hasp = tpos > 0, hasn = tpos < L - 1;
#pragma unroll
        for (int hh = 0; hh < 2; ++hh) { const int ch = 8 * lane + 512 * hh;
            const bf16x8 zc = *(const bf16x8*)(Z + (size_t)m * D + ch), bgv = *(const bf16x8*)(BG + (size_t)m * D + ch);
            bf16x8 zp = zc, zn = zc; if (hasp) zp = *(const bf16x8*)(Z + (size_t)(m - 1) * D + ch); if (hasn) zn = *(const bf16x8*)(Z + (size_t)(m + 1) * D + ch);
            float r[8];
#pragma unroll
            for (int e = 0; e < 8; ++e) { float v = cb[ch + e] + bf2f((unsigned short)zc[e]) * cw[D + ch + e];
                if (hasp) v += bf2f((unsigned short)zp[e]) * cw[ch + e]; if (hasn) v += bf2f((unsigned short)zn[e]) * cw[2 * D + ch + e];
                r[e] = v * bf2f((unsigned short)bgv[e]); }
            u32x4 w; w.x = cvt_pk_bf16(r[0], r[1]); w.y = cvt_pk_bf16(r[2], r[3]); w.z = cvt_pk_bf16(r[4], r[5]); w.w = cvt_pk_bf16(r[6], r[7]);
            *(u32x4*)(A2 + (size_t)m * D + ch) = w; }
    }
}
template <bool LOCAL>
__device__ __forceinline__ void attn_tile(const bf16x8 (&qf)[4], const bf16* kp, const bf16* vp, size_t vpitch, f32x16& o0, f32x16& o1, float& mrun, float& lsum,
                                          const LAS float* rp, int ck0, int cq, int cs) {
    const bf16x8 k0 = *(const bf16x8*)(kp), k1 = *(const bf16x8*)(kp + 16), k2 = *(const bf16x8*)(kp + 32), k3 = *(const bf16x8*)(kp + 48);
    const bf16* vp1 = vp + 32 * vpitch;
    const s16x4 a00 = *(const s16x4*)(vp), a01 = *(const s16x4*)(vp + 8), a02 = *(const s16x4*)(vp + 16), a03 = *(const s16x4*)(vp + 24);
    const s16x4 a10 = *(const s16x4*)(vp1), a11 = *(const s16x4*)(vp1 + 8), a12 = *(const s16x4*)(vp1 + 16), a13 = *(const s16x4*)(vp1 + 24);
    f32x16 s;
#pragma unroll
    for (int i = 0; i < 16; ++i) s[i] = 0.f;
    s = MFMA32(k0, qf[0], s); s = MFMA32(k1, qf[1], s); s = MFMA32(k2, qf[2], s); s = MFMA32(k3, qf[3], s);
    if (LOCAL) {
#pragma unroll
        for (int i = 0; i < 16; ++i) { const int ck = ck0 + 8 * (i >> 2) + (i & 3); const bool ok = (ck >= cs) && (ck < cs + 16);
            int idx = ck - cq + 15; idx = idx < 0 ? 0 : (idx > 30 ? 30 : idx);
            s[i] = ok ? s[i] + rp[idx] : -INFINITY; }
    }
    float mx = s[0];
#pragma unroll
    for (int i = 1; i < 16; ++i) mx = fmaxf(mx, s[i]);
    mx = fmaxf(mx, __shfl_xor(mx, 32));
    const float mn = fmaxf(mrun, mx), sc = __builtin_amdgcn_exp2f(mrun - mn); mrun = mn;
    float ps = 0.f;
#pragma unroll
    for (int i = 0; i < 16; ++i) { s[i] = __builtin_amdgcn_exp2f(s[i] - mn); ps += s[i]; }
    lsum = lsum * sc + ps; o0 *= sc; o1 *= sc;
    bf16x8 pb0, pb1;
    { u32x4 w; w.x = cvt_pk_bf16(s[0], s[1]); w.y = cvt_pk_bf16(s[2], s[3]); w.z = cvt_pk_bf16(s[4], s[5]); w.w = cvt_pk_bf16(s[6], s[7]); pb0 = __builtin_bit_cast(bf16x8, w);
      w.x = cvt_pk_bf16(s[8], s[9]); w.y = cvt_pk_bf16(s[10], s[11]); w.z = cvt_pk_bf16(s[12], s[13]); w.w = cvt_pk_bf16(s[14], s[15]); pb1 = __builtin_bit_cast(bf16x8, w); }
    o0 = MFMA32(__builtin_shufflevector(a00, a01, 0, 1, 2, 3, 4, 5, 6, 7), pb0, o0); o0 = MFMA32(__builtin_shufflevector(a02, a03, 0, 1, 2, 3, 4, 5, 6, 7), pb1, o0);
    o1 = MFMA32(__builtin_shufflevector(a10, a11, 0, 1, 2, 3, 4, 5, 6, 7), pb0, o1); o1 = MFMA32(__builtin_shufflevector(a12, a13, 0, 1, 2, 3, 4, 5, 6, 7), pb1, o1);
}
__device__ __forceinline__ void attn_phase(const Args& a, LAS unsigned char* lds, int tid, int lane, int wave, int G) {
    const bf16* Q = (const bf16*)(a.ws + WS_BUF1); const bf16* Kb = Q + (size_t)T * D; const bf16* VT = Kb + (size_t)T * D;
    const bf16* CKB = (const bf16*)(a.ws + WS_CKB); const bf16* CVT = (const bf16*)(a.ws + WS_CVT);
    bf16* O = (bf16*)(a.ws + WS_BUF2);
    LAS float* rpl = (LAS float*)lds;
    const int l31 = lane & 31, hf = lane >> 5;
    { float* nck = a.out + (size_t)T * D; float* ncv = nck + (size_t)TP * D;
      for (int e = blockIdx.x * 512 + tid; e < TP * D / 8; e += G * 512) { const bf16x8 v = *((const bf16x8*)Kb + e); f32x4 lo, hi;
#pragma unroll
          for (int i = 0; i < 4; ++i) { lo[i] = bf2f((unsigned short)v[i]); hi[i] = bf2f((unsigned short)v[4 + i]); }
          *((f32x4*)nck + 2 * e) = lo; *((f32x4*)nck + 2 * e + 1) = hi; }
      LAS float* scr = (LAS float*)(lds + 2048 + wave * 8704);
      for (int item = blockIdx.x * 8 + wave; item < 2048; item += G * 8) { const int ch0 = (item >> 6) * 32, tok0 = (item & 63) * 64;
#pragma unroll 4
          for (int i = 0; i < 16; ++i) { const int cr = 2 * i + hf; const unsigned w = *(const unsigned*)(VT + (size_t)(ch0 + cr) * T + tok0 + 2 * l31);
              scr[(2 * l31) * 33 + cr] = __uint_as_float(w << 16); scr[(2 * l31 + 1) * 33 + cr] = __uint_as_float(w & 0xffff0000u); }
          LDS_WAIT(); asm volatile("" ::: "memory");
#pragma unroll 4
          for (int i = 0; i < 32; ++i) { const int tr = 2 * i + hf; ncv[(size_t)(tok0 + tr) * D + ch0 + l31] = scr[tr * 33 + l31]; }
          LDS_WAIT(); asm volatile("" ::: "memory"); } }
    for (int unit = blockIdx.x; unit < 768; unit += G) {
        int qrow, h;
        f32x16 o0, o1;
#pragma unroll
        for (int i = 0; i < 16; ++i) { o0[i] = 0.f; o1[i] = 0.f; }
        float mrun = -1e30f, lsum = 0.f;
        bf16x8 qf[4];
        if (unit < 512) {
            const int b = unit >> 6; h = (unit >> 2) & 15; const int r = 4 * (unit & 3) + (wave >> 1), half = wave & 1;
            __syncthreads();
            if (tid < 465) rpl[tid] = a.in[I_RPB][h * 465 + tid] * LOG2E;
            __syncthreads();
            const int tb = TP + b * 1024;
            qrow = tb + r * 64 + 32 * half + l31;
            const bf16* qp = Q + (size_t)qrow * D + h * 64 + 8 * hf;
#pragma unroll
            for (int ks = 0; ks < 4; ++ks) qf[ks] = *(const bf16x8*)(qp + 16 * ks);
            const bf16* kp = CKB + ((size_t)b * 512 + l31) * D + h * 64 + 8 * hf;
            const bf16* vp = CVT + ((size_t)b * D + h * 64 + l31) * 512 + 4 * hf;
            for (int t = 0; t < 16; ++t) attn_tile<false>(qf, kp + (size_t)t * 32 * D, vp + t * 32, 512, o0, o1, mrun, lsum, rpl, 0, 0, 0);
            int start = r - 4; start = start < 0 ? 0 : (start > 8 ? 8 : start);
            const int cq = 32 * half + l31; int cs = cq - 8; cs = cs < 0 ? 0 : (cs > 48 ? 48 : cs);
            for (int t = 0; t < 16; ++t) { const int rr = start + (t >> 1), kh = t & 1; const int tok0 = tb + rr * 64 + 32 * kh;
                attn_tile<true>(qf, Kb + (size_t)(tok0 + l31) * D + h * 64 + 8 * hf, VT + (size_t)(h * 64 + l31) * T + tok0 + 4 * hf, T, o0, o1, mrun, lsum, rpl + (rr - r + 7) * 31, 32 * kh + 4 * hf, cq, cs); }
        } else {
            const int b = (unit - 512) >> 4; h = (unit - 512) & 15;
            qrow = b * 256 + 32 * wave + l31;
            const bf16* qp = Q + (size_t)qrow * D + h * 64 + 8 * hf;
#pragma unroll
            for (int ks = 0; ks < 4; ++ks) qf[ks] = *(const bf16x8*)(qp + 16 * ks);
            for (int t = 0; t < 8; ++t) { const int tok0 = b * 256 + 32 * t;
                attn_tile<false>(qf, Kb + (size_t)(tok0 + l31) * D + h * 64 + 8 * hf, VT + (size_t)(h * 64 + l31) * T + tok0 + 4 * hf, T, o0, o1, mrun, lsum, rpl, 0, 0, 0); }
        }
        const float inv = 1.0f / (lsum + __shfl_xor(lsum, 32));
        bf16* op = O + (size_t)qrow * D + h * 64 + 4 * hf;
#pragma unroll
        for (int b4 = 0; b4 < 4; ++b4) {
            u32x2 w; w.x = cvt_pk_bf16(o0[4 * b4] * inv, o0[4 * b4 + 1] * inv); w.y = cvt_pk_bf16(o0[4 * b4 + 2] * inv, o0[4 * b4 + 3] * inv); *(u32x2*)(op + 8 * b4) = w;
            w.x = cvt_pk_bf16(o1[4 * b4] * inv, o1[4 * b4 + 1] * inv); w.y = cvt_pk_bf16(o1[4 * b4 + 2] * inv, o1[4 * b4 + 3] * inv); *(u32x2*)(op + 32 + 8 * b4) = w; }
    }
}
struct EpiU {
    static constexpr bool PERM = true, AFTER_DRAIN = false;
    int type; int ldc; bf16* b0; bf16* b1; const float* f0; const float* f1; float* o0;
    __device__ __forceinline__ void operator()(ACC_T, const pg8::Unit& u, int wr_, int wc_, int fr_, int fq_) const {
        int wr = wr_, wc = wc_, fr = fr_, fq = fq_; asm volatile("" : "+s"(wr), "+s"(wc), "+v"(fr), "+v"(fq));
        switch (type) {
            case 0: { EpiAct<1> E{b0, ldc}; E(acc, u, wr, wc, fr, fq); } break;
            case 1: { EpiAct<2> E{b0, ldc}; E(acc, u, wr, wc, fr, fq); } break;
            case 2: { EpiVT E{b0, o0}; E(acc, u, wr, wc, fr, fq); } break;
            case 3: { EpiRes E{o0, f0}; E(acc, u, wr, wc, fr, fq); } break;
            case 4: { EpiQK E{b0, b1, f0, f1, o0}; E(acc, u, wr, wc, fr, fq); } break;
            case 5: { EpiVTattn E{b0, o0}; E(acc, u, wr, wc, fr, fq); } break;
            default: { EpiConvIn E{b0, b1}; E(acc, u, wr, wc, fr, fq); } break;
        }
    }
};
#ifndef EN
#define EN 0xffff
#endif
__global__ void __launch_bounds__(512, 2) fwd_kernel(Args a) {
    extern __shared__ __attribute__((aligned(16))) unsigned char lds_raw[];
    LAS unsigned char* lds = (LAS unsigned char*)lds_raw;
    cg::grid_group grid = cg::this_grid();
    const int G = gridDim.x;
    unsigned char* ws = a.ws;
    for (int ph = a.ph_lo; ph < a.ph_hi; ++ph) {
        int tid = threadIdx.x; asm volatile("" : "+v"(tid));
        const int lane = tid & 63, wave = __builtin_amdgcn_readfirstlane(tid >> 6);
        bf16* H = (bf16*)(ws + WS_H); bf16* B1 = (bf16*)(ws + WS_BUF1); bf16* B2 = (bf16*)(ws + WS_BUF2);
        if (ph == 0) { if (EN & 1) p0_prologue(a, lds, tid, lane, wave, G); }
        else {
            const int l = (ph - 1) / 7, s = (ph - 1) % 7, kind = l % 3, j = l / 3;
            const float* modl = (const float*)(ws + WS_MOD) + (size_t)l * NCOND * MODW;
            if (s == 0 || s == 4) { if (EN & 2) norm_phase(a, l, s == 4, ph == 1, lane, wave, G); }
            else if (s == 2) {
                if (kind == 0) { if (EN & 512) gating_phase(a, j, lds, tid, lane, wave, G); }
                else if (kind == 1) { if (EN & 1024) attn_phase(a, lds, tid, lane, wave, G); }
                else { if (EN & 2048) conv_phase(a, j, lane, wave, G); }
            } else if (EN & 4) {
                for (int gi = 0; gi < 2; ++gi) {
                    const bf16* A = H; const bf16* Bt; int M = T, N, K = D, shift = 0; EpiU E{};
                    if (s == 5) { if (gi) break; Bt = (const bf16*)(ws + WS_WF1 + (size_t)l * 8 * MiB); N = FF; E.type = 1; E.b0 = B1; E.ldc = FF; }
                    else if (s == 6) { if (gi) break; A = B1; Bt = (const bf16*)(ws + WS_WF2 + (size_t)l * 8 * MiB); N = D; K = FF; E.type = 3; E.o0 = a.out; E.f0 = modl + 5 * D; }
                    else if (s == 3) { if (gi) break; A = B2; Bt = (const bf16*)(ws + (kind == 0 ? WS_WA_OUT + (size_t)j * 4 * MiB : (kind == 1 ? WS_WB_O : WS_WC_OUT))); N = D; K = kind == 0 ? AH : D; E.type = 3; E.o0 = a.out; E.f0 = modl + 2 * D; }
                    else if (kind == 0) { const bf16* W = (const bf16*)(ws + WS_WA_IN + (size_t)j * 8 * MiB);
                        if (gi == 0) { Bt = W; N = AH; E.type = 0; E.b0 = B1; E.ldc = AH; }
                        else { A = W + (size_t)AH * D; Bt = H; M = AH; N = T; shift = 128; E.type = 2; E.b0 = B1 + (size_t)T * AH; E.o0 = (float*)(ws + WS_PART); } }
                    else if (kind == 1) { const bf16* W = (const bf16*)(ws + WS_WB_QKV);
                        if (gi == 0) { Bt = W; N = 2048; E.type = 4; E.b0 = B1; E.b1 = B1 + (size_t)T * D; E.f0 = a.in[I_BQG] + j * 64; E.f1 = a.in[I_BKG] + j * 64; E.o0 = a.out + (size_t)T * D; }
                        else { A = W + (size_t)2048 * D; Bt = H; M = D; N = T; shift = 128; E.type = 5; E.b0 = B1 + (size_t)2 * T * D; E.o0 = a.out + (size_t)T * D + (size_t)TP * D; } }
                    else { if (gi) break; Bt = (const bf16*)(ws + WS_WC_IN); N = 3072; E.type = 6; E.b0 = B1; E.b1 = B1 + (size_t)T * D; }
                    pg8::Gemm g{A, Bt, M, N, K}; pg8::StaticOrder S; S.init(M, N, G, (int)((blockIdx.x + shift) % G));
                    pg8::gemm_phase<EpiU, pg8::StaticOrder, true, true>(lds, g, S, E);
                }
            }
        }
        if (ph + 1 < a.ph_hi) grid.sync();
    }
}

#ifndef N_LAUNCH_MODE
#define N_LAUNCH_MODE 1
#endif
extern "C" void kernel_launch(void* const* d_in, const int* in_sizes, int n_in, void* d_out, int out_size, void* d_ws, size_t ws_size, hipStream_t stream) {
    static int grid = 0;
    if (grid == 0) {
        if (n_in != 25 || ws_size < WS_END) { fprintf(stderr, "kernel_launch: unexpected n_in %d or ws_size %zu\n", n_in, ws_size); grid = -1; return; }
        int dev = 0, cus = 0, per_cu = 0;
        hipGetDevice(&dev); hipDeviceGetAttribute(&cus, hipDeviceAttributeMultiprocessorCount, dev);
        if (hipFuncSetAttribute((const void*)fwd_kernel, hipFuncAttributeMaxDynamicSharedMemorySize, LDS_BYTES) != hipSuccess) { fprintf(stderr, "kernel_launch: hipFuncSetAttribute failed\n"); grid = -1; return; }
        if (hipOccupancyMaxActiveBlocksPerMultiprocessor(&per_cu, (const void*)fwd_kernel, 512, LDS_BYTES) != hipSuccess || per_cu < 1) { fprintf(stderr, "kernel_launch: occupancy query says %d\n", per_cu); per_cu = 1; }
        (void)hipGetLastError();
        grid = cus * per_cu;
        fprintf(stderr, "kernel_launch: grid %d (cus %d x %d)\n", grid, cus, per_cu);
    }
    if (grid < 0) return;
    Args a{};
    for (int i = 0; i < 25; ++i) a.in[i] = (const float*)d_in[i];
    a.out = (float*)d_out; a.ws = (unsigned char*)d_ws;
#if N_LAUNCH_MODE == 1
    a.ph_lo = 0; a.ph_hi = NPHASE;
    void* args[] = {&a};
    hipError_t e = hipLaunchCooperativeKernel((const void*)fwd_kernel, dim3(grid), dim3(512), args, LDS_BYTES, stream);
    if (e != hipSuccess) fprintf(stderr, "cooperative launch failed: %s (grid %d)\n", hipGetErrorString(e), grid);
#else
    for (int ph = 0; ph < NPHASE; ++ph) { a.ph_lo = ph; a.ph_hi = ph + 1; hipLaunchKernelGGL(fwd_kernel, dim3(grid), dim3(512), LDS_BYTES, stream, a); }
#endif
}
```

```cpp
#include <hip/hip_runtime.h>
#include <hip/hip_cooperative_groups.h>
#include <cstdio>
#include <cstdint>
namespace cg = cooperative_groups;

namespace pg8 {
#define PG8_LAS __attribute__((address_space(3)))
typedef unsigned short bf16_t;
typedef short bf16x8 __attribute__((ext_vector_type(8)));
typedef float f32x4 __attribute__((ext_vector_type(4)));
typedef unsigned u32x4 __attribute__((ext_vector_type(4)));
constexpr int BM = 256, BK = 64, HALF = 128, HTB = HALF * BK * 2  , STAGE_BYTES = 8 * HTB, NXCD = 8, WGM = 8;

__host__ __device__ __forceinline__ int lds_byte(int r, int c) { const int st = (r >> 4) * 2 + (c >> 5), rr = r & 15, cc = c & 31, ob = rr * 64 + cc * 2; return st * 1024 + (ob ^ (((ob >> 9) & 1) << 5)); }
__host__ __device__ __forceinline__ void stage_rc(int b, int& R, int& C) { const int st = b / 1024, sb = b % 1024, swz = sb ^ (((sb >> 9) & 1) << 5); R = (st >> 1) * 16 + swz / 64; C = (st & 1) * 32 + (swz % 64) / 2; }
__host__ __device__ __forceinline__ int perm32(int rho) { const int n = rho >> 4, i = rho & 15; return 8 * (i >> 2) + 4 * n + (i & 3); }

struct Unit { int pm, pn; };
struct Gemm { const bf16_t* A; const bf16_t* Bt; int M, N, K; };

struct StaticOrder {
    int nM, nN, nwg, G, c;
    __host__ __device__ void init(int M, int N, int G_, int c_) { nM = M / BM; nN = N / BM; nwg = nM * nN; G = G_; c = c_; }
    __host__ __device__ bool next(int i, Unit& u) const {
        const long L = (long)i * G + c; if (L >= nwg) return false;
        int wgid = (int)L; { const int q = nwg / NXCD, r = nwg % NXCD, xcd = wgid % NXCD, off = wgid / NXCD; wgid = (xcd < r ? xcd * (q + 1) : r * (q + 1) + (xcd - r) * q) + off; }
        const int nig = WGM * nN, gid = wgid / nig, fm = gid * WGM, gsz = (nM - fm) < WGM ? (nM - fm) : WGM;
        u.pm = fm + ((wgid % nig) % gsz); u.pn = (wgid % nig) / gsz; return true;
    }
    __device__ __forceinline__ void a_ready(const Unit&) const {}
    __device__ __forceinline__ void done(const Unit&) const {}
};

__device__ __forceinline__ unsigned cvt_pk_bf16(float lo, float hi) { unsigned r; asm volatile("v_cvt_pk_bf16_f32 %0, %1, %2" : "=v"(r) : "v"(lo), "v"(hi)); return r; }

template <class Epi, class Sched, bool ALIGN_EPI = false, bool SP2 = false>
__device__ __forceinline__ void gemm_phase(PG8_LAS unsigned char* lds, const Gemm g, const Sched& S, const Epi& E) {
    const int tid = threadIdx.x, wid = __builtin_amdgcn_readfirstlane(tid >> 6), lane = tid & 63, wr = wid >> 2, wc = wid & 3, fr = lane & 15, fq = lane >> 4;
    const int K = g.K, nt = K / BK;
    unsigned voffA[2], voffB[2];
#pragma unroll
    for (int i = 0; i < 2; ++i) { int R, C; stage_rc(tid * 16 + i * 8192, R, C); const int Rb = Epi::PERM ? ((R & ~31) + perm32(R & 31)) : R;
        voffA[i] = (unsigned)(R * K + C) * 2u; voffB[i] = (unsigned)(Rb * K + C) * 2u; }
    const size_t kstep = (size_t)(BK * 2);
    const size_t hstep = (size_t)HALF * K * 2;
    const size_t tstep = 2 * hstep;
    const unsigned ldsw = (unsigned)wid * 1024u;
    const int aoff = lds_byte(wr * 64 + fr, fq * 8), boff = lds_byte(wc * 32 + fr, fq * 8);
#define PG8_SA(b, h) (((b) * 2 + (h)) * HTB)
#define PG8_SB(b, h) ((4 + (b) * 2 + (h)) * HTB)
#define PG8_STAGE(bufoff, gbase, voff) do { _Pragma("unroll") for (int _i = 0; _i < 2; ++_i) \
        __builtin_amdgcn_global_load_lds((const unsigned*)((const char*)(gbase) + (voff)[_i]), (PG8_LAS unsigned*)(lds + (bufoff) + ldsw + _i * 8192), 16, 0, 0); } while (0)
#define PG8_LDA(dst, b, h) do { _Pragma("unroll") for (int m = 0; m < 4; ++m) _Pragma("unroll") for (int k = 0; k < 2; ++k) dst[m][k] = *(const PG8_LAS bf16x8*)(lds + PG8_SA(b, h) + aoff + m * 2048 + k * 1024); } while (0)
#define PG8_LDB(dst, b, h) do { _Pragma("unroll") for (int n = 0; n < 2; ++n) _Pragma("unroll") for (int k = 0; k < 2; ++k) dst[n][k] = *(const PG8_LAS bf16x8*)(lds + PG8_SB(b, h) + boff + n * 2048 + k * 1024); } while (0)
#define PG8_MMA(ai, bj, At, Bt) do { __builtin_amdgcn_s_setprio(1); _Pragma("unroll") for (int m = 0; m < 4; ++m) _Pragma("unroll") for (int n = 0; n < 2; ++n) _Pragma("unroll") for (int k = 0; k < 2; ++k) \
        acc[ai][bj][m][n] = __builtin_amdgcn_mfma_f32_16x16x32_bf16(Bt[n][k], At[m][k], acc[ai][bj][m][n], 0, 0, 0); __builtin_amdgcn_s_setprio(0); } while (0)
#define PG8_WAIT_V(n) asm volatile("s_waitcnt vmcnt(" #n ")" ::: "memory")
#define PG8_WAIT_L(n) asm volatile("s_waitcnt lgkmcnt(" #n ")" ::: "memory")
#define PG8_BAR __builtin_amdgcn_s_barrier()
#define PG8_SCHED __builtin_amdgcn_sched_barrier(0)
    Unit cur, nxt; int ui = 0;
    if (!S.next(0, cur)) return;
    f32x4 acc[2][2][4][2];
#pragma unroll
    for (int a = 0; a < 2; ++a)
#pragma unroll
        for (int b = 0; b < 2; ++b)
#pragma unroll
            for (int m = 0; m < 4; ++m)
#pragma unroll
                for (int n = 0; n < 2; ++n) acc[a][b][m][n] = (f32x4){0.f, 0.f, 0.f, 0.f};
    bf16x8 At[4][2], B0[2][2], B1[2][2];
    const char* cA = (const char*)g.A + (size_t)cur.pm * tstep; const char* cB = (const char*)g.Bt + (size_t)cur.pn * tstep;
    S.a_ready(cur);
    if constexpr (SP2) {
        PG8_STAGE(PG8_SB(0, 0), cB, voffB); PG8_STAGE(PG8_SB(0, 1), cB + hstep, voffB); PG8_STAGE(PG8_SA(0, 0), cA, voffA); PG8_STAGE(PG8_SA(0, 1), cA + hstep, voffA);
        if (wr == 1) PG8_BAR;
        PG8_WAIT_V(2); PG8_BAR;
        PG8_STAGE(PG8_SB(1, 0), cB + kstep, voffB); PG8_STAGE(PG8_SA(1, 0), cA + kstep, voffA); PG8_STAGE(PG8_SB(1, 1), cB + hstep + kstep, voffB);
        PG8_WAIT_V(6); PG8_BAR;
    } else {
        PG8_STAGE(PG8_SB(0, 0), cB, voffB); PG8_STAGE(PG8_SA(0, 0), cA, voffA); PG8_STAGE(PG8_SB(0, 1), cB + hstep, voffB); PG8_STAGE(PG8_SA(0, 1), cA + hstep, voffA);
        if (wr == 1) PG8_BAR;
        PG8_WAIT_V(4); PG8_BAR;
        PG8_STAGE(PG8_SB(1, 0), cB + kstep, voffB); PG8_STAGE(PG8_SA(1, 0), cA + kstep, voffA); PG8_STAGE(PG8_SB(1, 1), cB + hstep + kstep, voffB);
        PG8_WAIT_V(6); PG8_BAR;
    }
    for (;;) {
        const bool has_next = S.next(ui + 1, nxt);
        const char* nA = has_next ? (const char*)g.A + (size_t)nxt.pm * tstep : cA; const char* nB = has_next ? (const char*)g.Bt + (size_t)nxt.pn * tstep : cB;
        for (int t = 0; t < nt; t += 2) {
            const bool last = (t == nt - 2);
            const char* a1 = cA + (size_t)(t + 1) * kstep;
            const char* a2 = last ? nA : cA + (size_t)(t + 2) * kstep; const char* b2 = last ? nB : cB + (size_t)(t + 2) * kstep;
            const char* a3 = a2 + kstep; const char* b3 = b2 + kstep;
            if (last && has_next) S.a_ready(nxt);
            if constexpr (SP2) {
            PG8_LDB(B0, 0, 0); PG8_LDB(B1, 0, 1); PG8_SCHED; PG8_LDA(At, 0, 0); PG8_STAGE(PG8_SA(1, 1), a1 + hstep, voffA);
            PG8_WAIT_V(8); PG8_WAIT_L(0); PG8_BAR; PG8_MMA(0, 0, At, B0); PG8_MMA(0, 1, At, B1); PG8_BAR; PG8_SCHED;
            PG8_LDA(At, 0, 1); PG8_STAGE(PG8_SB(0, 0), b2, voffB); PG8_STAGE(PG8_SB(0, 1), b2 + hstep, voffB); PG8_STAGE(PG8_SA(0, 0), a2, voffA);
            PG8_WAIT_V(8); PG8_WAIT_L(0); PG8_BAR; PG8_MMA(1, 0, At, B0); PG8_MMA(1, 1, At, B1); PG8_BAR; PG8_SCHED;
            PG8_LDB(B0, 1, 0); PG8_LDB(B1, 1, 1); PG8_SCHED; PG8_LDA(At, 1, 0); PG8_STAGE(PG8_SA(0, 1), a2 + hstep, voffA);
            PG8_WAIT_V(8); PG8_WAIT_L(0); PG8_BAR; PG8_MMA(0, 0, At, B0); PG8_MMA(0, 1, At, B1); PG8_BAR; PG8_SCHED;
            PG8_LDA(At, 1, 1); PG8_STAGE(PG8_SB(1, 0), b3, voffB); PG8_STAGE(PG8_SB(1, 1), b3 + hstep, voffB); PG8_STAGE(PG8_SA(1, 0), a3, voffA);
            PG8_WAIT_V(8); PG8_WAIT_L(0); PG8_BAR; PG8_MMA(1, 0, At, B0); PG8_MMA(1, 1, At, B1); PG8_BAR; PG8_SCHED;
            } else {
            PG8_LDB(B0, 0, 0); PG8_SCHED; PG8_LDA(At, 0, 0); PG8_STAGE(PG8_SA(1, 1), a1 + hstep, voffA);
            PG8_WAIT_L(8); PG8_BAR; PG8_WAIT_L(0); PG8_MMA(0, 0, At, B0); PG8_BAR; PG8_SCHED;
            PG8_LDB(B1, 0, 1); PG8_STAGE(PG8_SB(0, 0), b2, voffB);
            PG8_BAR; PG8_WAIT_L(0); PG8_MMA(0, 1, At, B1); PG8_BAR;
            PG8_LDA(At, 0, 1); PG8_STAGE(PG8_SA(0, 0), a2, voffA);
            PG8_BAR; PG8_WAIT_L(0); PG8_MMA(1, 0, At, B0); PG8_BAR; PG8_SCHED;
            PG8_STAGE(PG8_SB(0, 1), b2 + hstep, voffB);
            PG8_WAIT_V(6); PG8_BAR; PG8_MMA(1, 1, At, B1); PG8_BAR;
            PG8_LDB(B0, 1, 0); PG8_SCHED; PG8_LDA(At, 1, 0); PG8_STAGE(PG8_SA(0, 1), a2 + hstep, voffA);
            PG8_WAIT_L(8); PG8_BAR; PG8_WAIT_L(0); PG8_MMA(0, 0, At, B0); PG8_BAR; PG8_SCHED;
            PG8_LDB(B1, 1, 1); PG8_STAGE(PG8_SB(1, 0), b3, voffB);
            PG8_BAR; PG8_WAIT_L(0); PG8_MMA(0, 1, At, B1); PG8_BAR;
            PG8_LDA(At, 1, 1); PG8_STAGE(PG8_SA(1, 0), a3, voffA);
            PG8_BAR; PG8_WAIT_L(0); PG8_MMA(1, 0, At, B0); PG8_BAR; PG8_SCHED;
            PG8_STAGE(PG8_SB(1, 1), b3 + hstep, voffB);
            PG8_WAIT_V(6); PG8_BAR; PG8_MMA(1, 1, At, B1); PG8_BAR;
            }
        }
        if constexpr (ALIGN_EPI) { if (wr == 0) PG8_BAR; }
        if constexpr (!Epi::AFTER_DRAIN) { E(acc, cur, wr, wc, fr, fq); S.done(cur); }
        if (!has_next) break;
#pragma unroll
        for (int a = 0; a < 2; ++a)
#pragma unroll
            for (int b = 0; b < 2; ++b)
#pragma unroll
                for (int m = 0; m < 4; ++m)
#pragma unroll
                    for (int n = 0; n < 2; ++n) acc[a][b][m][n] = (f32x4){0.f, 0.f, 0.f, 0.f};
        cur = nxt; cA = nA; cB = nB; ++ui;
        if constexpr (ALIGN_EPI) { if (wr == 1) PG8_BAR; }
    }
    PG8_WAIT_V(0);
    if constexpr (!ALIGN_EPI) { if (wr == 0) PG8_BAR; }
    PG8_BAR;
    if constexpr (Epi::AFTER_DRAIN) { E.fused(acc, cur, wr, wc, fr, fq, lds, wid, lane); S.done(cur); }
#undef PG8_SA
#undef PG8_SB
#undef PG8_STAGE
#undef PG8_LDA
#undef PG8_LDB
#undef PG8_MMA
#undef PG8_WAIT_V
#undef PG8_WAIT_L
#undef PG8_BAR
#undef PG8_SCHED
}
}
#define LAS __attribute__((address_space(3)))
typedef unsigned short bf16;
typedef float f32x4 __attribute__((ext_vector_type(4)));
typedef float f32x2 __attribute__((ext_vector_type(2)));
typedef float f32x16 __attribute__((ext_vector_type(16)));
typedef short bf16x8 __attribute__((ext_vector_type(8)));
typedef short s16x4 __attribute__((ext_vector_type(4)));
typedef unsigned u32x4 __attribute__((ext_vector_type(4)));
typedef unsigned u32x2 __attribute__((ext_vector_type(2)));

constexpr int D = 1024, TP = 4096, TS = 8192, T = 12288, FF = 4096, AH = 2048, NCOND = 9, MODW = 6144;
constexpr float EPS = 1e-6f, LOG2E = 1.4426950408889634f;
constexpr size_t MiB = 1u << 20;
constexpr size_t WS_CTL = 0, WS_MOD = 1 * MiB, WS_PART = 2 * MiB;
constexpr size_t WS_WA_IN = 4 * MiB, WS_WA_OUT = 20 * MiB, WS_WB_QKV = 28 * MiB, WS_WB_O = 34 * MiB, WS_WC_IN = 36 * MiB, WS_WC_OUT = 42 * MiB;
constexpr size_t WS_WF1 = 44 * MiB, WS_WF2 = 76 * MiB, WS_CKB = 108 * MiB, WS_CVT = 116 * MiB, WS_H = 124 * MiB, WS_BUF1 = 148 * MiB, WS_BUF2 = 244 * MiB, WS_END = 292 * MiB;
constexpr int LDS_BYTES = 147456;
constexpr int NPHASE = 29;

using pg8::cvt_pk_bf16;
__device__ __forceinline__ float bf2f(unsigned short b) { return __uint_as_float((unsigned)b << 16); }
__device__ __forceinline__ float gelu_tanh(float x) {
    const float t = x * x, w = x * (0.7978845608f + 0.0356774081f * t);
    const float e = __builtin_amdgcn_exp2f(-2.885390082f * w);
    return x * __builtin_amdgcn_rcpf(1.0f + e);
}
__device__ __forceinline__ int cond_of_tile(int pm) { return pm < 16 ? 8 : ((pm - 16) >> 2); }
__device__ __forceinline__ int cond_of_row(int m) { return m < TP ? 8 : ((m - TP) >> 10); }

typedef pg8::f32x4 af4;
#define ACC_T const pg8::f32x4 (&acc)[2][2][4][2]
template <int ACT> struct EpiAct {
    static constexpr bool PERM = true, AFTER_DRAIN = false;
    bf16* O; int ldc;
    __device__ __forceinline__ void operator()(ACC_T, const pg8::Unit& u, int wr, int wc, int fr, int fq) const {
        const int row0 = u.pm * 256 + wr * 64 + fr, col0 = u.pn * 256 + wc * 32 + 8 * fq;
#pragma unroll
        for (int ai = 0; ai < 2; ++ai)
#pragma unroll
            for (int m = 0; m < 4; ++m) { bf16* rowp = O + (size_t)(row0 + ai * 128 + m * 16) * ldc + col0;
#pragma unroll
                for (int bj = 0; bj < 2; ++bj) { af4 v0 = acc[ai][bj][m][0], v1 = acc[ai][bj][m][1];
                    if (ACT == 1) {
#pragma unroll
                        for (int i = 0; i < 4; ++i) { v0[i] = gelu_tanh(v0[i]); v1[i] = gelu_tanh(v1[i]); } }
                    if (ACT == 2) {
#pragma unroll
                        for (int i = 0; i < 4; ++i) { float a = fmaxf(v0[i], 0.f), b = fmaxf(v1[i], 0.f); v0[i] = a * a; v1[i] = b * b; } }
                    u32x4 w; w.x = cvt_pk_bf16(v0[0], v0[1]); w.y = cvt_pk_bf16(v0[2], v0[3]); w.z = cvt_pk_bf16(v1[0], v1[1]); w.w = cvt_pk_bf16(v1[2], v1[3]);
                    *(u32x4*)(rowp + bj * 128) = w; } }
    }
};
struct EpiVT {
    static constexpr bool PERM = true, AFTER_DRAIN = false;
    bf16* O; float* part;
    __device__ __forceinline__ void operator()(ACC_T, const pg8::Unit& u, int wr, int wc, int fr, int fq) const {
        const int row0 = u.pm * 256 + wr * 64 + fr, col0 = u.pn * 256 + wc * 32 + 8 * fq;
        float cs[2][2][4];
#pragma unroll
        for (int bj = 0; bj < 2; ++bj)
#pragma unroll
            for (int n = 0; n < 2; ++n)
#pragma unroll
                for (int i = 0; i < 4; ++i) cs[bj][n][i] = 0.f;
#pragma unroll
        for (int ai = 0; ai < 2; ++ai)
#pragma unroll
            for (int m = 0; m < 4; ++m) { bf16* rowp = O + (size_t)(row0 + ai * 128 + m * 16) * T + col0;
#pragma unroll
                for (int bj = 0; bj < 2; ++bj) { af4 v0 = acc[ai][bj][m][0], v1 = acc[ai][bj][m][1];
#pragma unroll
                    for (int i = 0; i < 4; ++i) { v0[i] = gelu_tanh(v0[i]); v1[i] = gelu_tanh(v1[i]); cs[bj][0][i] += v0[i] * v0[i]; cs[bj][1][i] += v1[i] * v1[i]; }
                    u32x4 w; w.x = cvt_pk_bf16(v0[0], v0[1]); w.y = cvt_pk_bf16(v0[2], v0[3]); w.z = cvt_pk_bf16(v1[0], v1[1]); w.w = cvt_pk_bf16(v1[2], v1[3]);
                    *(u32x4*)(rowp + bj * 128) = w; }
                asm volatile("" : "+v"(cs[0][0][0]), "+v"(cs[0][0][1]), "+v"(cs[0][0][2]), "+v"(cs[0][0][3]), "+v"(cs[0][1][0]), "+v"(cs[0][1][1]), "+v"(cs[0][1][2]), "+v"(cs[0][1][3]),
                             "+v"(cs[1][0][0]), "+v"(cs[1][0][1]), "+v"(cs[1][0][2]), "+v"(cs[1][0][3]), "+v"(cs[1][1][0]), "+v"(cs[1][1][1]), "+v"(cs[1][1][2]), "+v"(cs[1][1][3])); }
#pragma unroll
        for (int bj = 0; bj < 2; ++bj)
#pragma unroll
            for (int n = 0; n < 2; ++n)
#pragma unroll
                for (int i = 0; i < 4; ++i) { float s = cs[bj][n][i]; s += __shfl_xor(s, 1); s += __shfl_xor(s, 2); s += __shfl_xor(s, 4); s += __shfl_xor(s, 8);
                    if (fr == 0) part[(size_t)(col0 + bj * 128 + 4 * n + i) * 16 + u.pm * 2 + wr] = s; }
    }
};
struct EpiRes {
    static constexpr bool PERM = true, AFTER_DRAIN = false;
    float* x; const float* gate;
    __device__ __forceinline__ void operator()(ACC_T, const pg8::Unit& u, int wr, int wc, int fr, int fq) const {
        const int row0 = u.pm * 256 + wr * 64 + fr, col0 = u.pn * 256 + wc * 32 + 8 * fq;
        const float* gp = gate + (size_t)cond_of_tile(u.pm) * MODW + col0;
        f32x4 g[2][2];
#pragma unroll
        for (int bj = 0; bj < 2; ++bj) { g[bj][0] = *(const f32x4*)(gp + bj * 128); g[bj][1] = *(const f32x4*)(gp + bj * 128 + 4); }
#pragma unroll
        for (int ai = 0; ai < 2; ++ai)
#pragma unroll
            for (int m = 0; m < 4; ++m) { float* rowp = x + (size_t)(row0 + ai * 128 + m * 16) * D + col0;
#pragma unroll
                for (int bj = 0; bj < 2; ++bj) { f32x4 x0 = *(const f32x4*)(rowp + bj * 128), x1 = *(const f32x4*)(rowp + bj * 128 + 4);
                    x0 += g[bj][0] * acc[ai][bj][m][0]; x1 += g[bj][1] * acc[ai][bj][m][1];
                    *(f32x4*)(rowp + bj * 128) = x0; *(f32x4*)(rowp + bj * 128 + 4) = x1; } }
    }
};
struct EpiQK {
    static constexpr bool PERM = true, AFTER_DRAIN = false;
    bf16* q; bf16* k; const float* qg; const float* kg; float* nck;
    __device__ __forceinline__ void operator()(ACC_T, const pg8::Unit& u, int wr, int wc, int fr, int fq) const {
        const bool isq = u.pn < 4; const int head = 4 * (u.pn & 3) + wc;
        bf16* dst = isq ? q : k; const float* gn = isq ? qg : kg; const float osc = isq ? 0.125f * LOG2E : 1.0f;
        f32x4 g[2][2];
#pragma unroll
        for (int bj = 0; bj < 2; ++bj) { g[bj][0] = *(const f32x4*)(gn + 32 * bj + 8 * fq); g[bj][1] = *(const f32x4*)(gn + 32 * bj + 8 * fq + 4); }
        const int row0 = u.pm * 256 + wr * 64 + fr, col0 = head * 64 + 8 * fq;
#pragma unroll
        for (int ai = 0; ai < 2; ++ai)
#pragma unroll
            for (int m = 0; m < 4; ++m) { const int row = row0 + ai * 128 + m * 16;
                float ss = 0.f;
#pragma unroll
                for (int bj = 0; bj < 2; ++bj)
#pragma unroll
                    for (int n = 0; n < 2; ++n) { const af4 v = acc[ai][bj][m][n]; ss += (v[0] * v[0] + v[1] * v[1]) + (v[2] * v[2] + v[3] * v[3]); }
                ss += __shfl_xor(ss, 16); ss += __shfl_xor(ss, 32);
                const float rstd = __builtin_amdgcn_rsqf(ss * (1.0f / 64.0f) + EPS);
#pragma unroll
                for (int bj = 0; bj < 2; ++bj) { f32x4 v0 = acc[ai][bj][m][0] * rstd * g[bj][0], v1 = acc[ai][bj][m][1] * rstd * g[bj][1];
                    v0 *= osc; v1 *= osc;
                    u32x4 w; w.x = cvt_pk_bf16(v0[0], v0[1]); w.y = cvt_pk_bf16(v0[2], v0[3]); w.z = cvt_pk_bf16(v1[0], v1[1]); w.w = cvt_pk_bf16(v1[2], v1[3]);
                    *(u32x4*)(dst + (size_t)row * D + col0 + 32 * bj) = w; } }
    }
};
struct EpiVTattn {
    static constexpr bool PERM = true, AFTER_DRAIN = false;
    bf16* O; float* ncv;
    __device__ __forceinline__ void operator()(ACC_T, const pg8::Unit& u, int wr, int wc, int fr, int fq) const {
        const int row0 = u.pm * 256 + wr * 64 + fr, col0 = u.pn * 256 + wc * 32 + 8 * fq;
#pragma unroll
        for (int ai = 0; ai < 2; ++ai)
#pragma unroll
            for (int m = 0; m < 4; ++m) { const int row = row0 + ai * 128 + m * 16; bf16* rowp = O + (size_t)row * T + col0;
#pragma unroll
                for (int bj = 0; bj < 2; ++bj) { const af4 v0 = acc[ai][bj][m][0], v1 = acc[ai][bj][m][1];
                    u32x4 w; w.x = cvt_pk_bf16(v0[0], v0[1]); w.y = cvt_pk_bf16(v0[2], v0[3]); w.z = cvt_pk_bf16(v1[0], v1[1]); w.w = cvt_pk_bf16(v1[2], v1[3]);
                    *(u32x4*)(rowp + bj * 128) = w; } }
    }
};
struct EpiConvIn {
    static constexpr bool PERM = true, AFTER_DRAIN = false;
    bf16* bg; bf16* z;
    __device__ __forceinline__ void operator()(ACC_T, const pg8::Unit& u, int wr, int wc, int fr, int fq) const {
        const int row0 = u.pm * 256 + wr * 64 + fr;
#pragma unroll
        for (int ai = 0; ai < 2; ++ai)
#pragma unroll
            for (int m = 0; m < 4; ++m) { const size_t row = (size_t)(row0 + ai * 128 + m * 16);
                if (u.pn < 4) {
#pragma unroll
                    for (int bj = 0; bj < 2; ++bj) { const af4 v0 = acc[ai][bj][m][0], v1 = acc[ai][bj][m][1];
                        u32x4 w; w.x = cvt_pk_bf16(v0[0], v0[1]); w.y = cvt_pk_bf16(v0[2], v0[3]); w.z = cvt_pk_bf16(v1[0], v1[1]); w.w = cvt_pk_bf16(v1[2], v1[3]);
                        *(u32x4*)(bg + row * D + u.pn * 256 + bj * 128 + wc * 32 + 8 * fq) = w; }
                } else {
                    const af4 v0 = acc[ai][0][m][0] * acc[ai][1][m][0], v1 = acc[ai][0][m][1] * acc[ai][1][m][1];
                    u32x4 w; w.x = cvt_pk_bf16(v0[0], v0[1]); w.y = cvt_pk_bf16(v0[2], v0[3]); w.z = cvt_pk_bf16(v1[0], v1[1]); w.w = cvt_pk_bf16(v1[2], v1[3]);
                    *(u32x4*)(z + row * D + (u.pn - 4) * 128 + wc * 32 + 8 * fq) = w; } }
    }
};
struct Args { const float* in[25]; float* out; unsigned char* ws; int ph_lo, ph_hi; };
enum { I_XP = 0, I_XS, I_CK, I_CV, I_C, I_CCTX, I_NORMG, I_ADAW, I_ADAB, I_AWIN, I_AVG, I_AWS, I_ABS, I_AWOUT, I_BWQKV, I_BQG, I_BKG, I_RPB, I_BWO, I_CWIN, I_CCW, I_CCB, I_CWOUT, I_FW1, I_FW2 };

#define LDS_WAIT() asm volatile("s_waitcnt lgkmcnt(0)" ::: "memory")
__device__ __forceinline__ float wave_sum(float v) {
#pragma unroll
    for (int o = 1; o < 64; o <<= 1) v += __shfl_xor(v, o);
    return v;
}
__device__ __forceinline__ int rowmap(int mode, int n) {
    if (mode == 1) { if (n >= 2048) return n; const int sect = n >> 10, hh = (n & 1023) >> 6, d = n & 63; return 256 * (sect * 4 + (hh >> 2)) + 128 * (d >> 5) + 32 * (hh & 3) + (d & 31); }
    if (mode == 2) { if (n < 1024) return n; const int s = (n >= 2048), ch = n - 1024 - 1024 * s; return 1024 + 256 * (ch >> 7) + 128 * s + (ch & 127); }
    return n;
}
__device__ __forceinline__ void transpose_item(const float* W, int K, int N, bf16* WT, int mode, LAS float* scr, int item, int lane) {
    const int nblk = N / 32, kb = item / nblk, nb = item % nblk, k0 = 64 * kb, n0 = 32 * nb;
#pragma unroll 8
    for (int i = 0; i < 32; ++i) { const int kk = 2 * i + (lane >> 5); scr[kk * 33 + (lane & 31)] = W[(size_t)(k0 + kk) * N + n0 + (lane & 31)]; }
    LDS_WAIT(); asm volatile("" ::: "memory");
    const int c = lane & 7; const int r0 = rowmap(mode, n0);
#pragma unroll
    for (int j = 0; j < 4; ++j) { const int n = (lane >> 3) + 8 * j; const LAS float* s = scr + (8 * c) * 33 + n;
        u32x4 o; o.x = cvt_pk_bf16(s[0 * 33], s[1 * 33]); o.y = cvt_pk_bf16(s[2 * 33], s[3 * 33]); o.z = cvt_pk_bf16(s[4 * 33], s[5 * 33]); o.w = cvt_pk_bf16(s[6 * 33], s[7 * 33]);
        *(u32x4*)(WT + (size_t)(r0 + n) * K + k0 + 8 * c) = o; }
    LDS_WAIT(); asm volatile("" ::: "memory");
}
__device__ __forceinline__ void p0_prologue(const Args& a, LAS unsigned char* lds, int tid, int lane, int wave, int G) {
    unsigned char* ws = a.ws;
    if ((int)blockIdx.x < 192) {
        LAS float* sc = (LAS float*)lds;
        LAS float* red = (LAS float*)(lds + 40960);
        for (int e = tid; e < NCOND * D; e += 512) { const int c = e >> 10, k = e & 1023; const float v = (c < 8) ? a.in[I_C][c * D + k] : a.in[I_CCTX][k]; sc[e] = v * __builtin_amdgcn_rcpf(1.0f + __builtin_amdgcn_exp2f(-LOG2E * v)); }
        __syncthreads();
        const int item = blockIdx.x, l = item / 48, n0 = (item % 48) * 128;
        const float* W = a.in[I_ADAW] + (size_t)l * D * MODW + n0 + 2 * lane;
        float acc0[NCOND], acc1[NCOND];
#pragma unroll
        for (int c = 0; c < NCOND; ++c) { acc0[c] = 0.f; acc1[c] = 0.f; }
        const int kbeg = wave * 128;
#pragma unroll 2
        for (int k = kbeg; k < kbeg + 128; k += 4) {
            const f32x2 w0 = *(const f32x2*)(W + (size_t)k * MODW), w1 = *(const f32x2*)(W + (size_t)(k + 1) * MODW), w2 = *(const f32x2*)(W + (size_t)(k + 2) * MODW), w3 = *(const f32x2*)(W + (size_t)(k + 3) * MODW);
#pragma unroll
            for (int c = 0; c < NCOND; ++c) { const f32x4 s = *(const LAS f32x4*)(sc + c * D + k);
                acc0[c] += s[0] * w0[0] + s[1] * w1[0] + s[2] * w2[0] + s[3] * w3[0]; acc1[c] += s[0] * w0[1] + s[1] * w1[1] + s[2] * w2[1] + s[3] * w3[1]; }
        }
#pragma unroll
        for (int c = 0; c < NCOND; ++c) { *(LAS f32x2*)(red + (wave * NCOND + c) * 128 + 2 * lane) = (f32x2){acc0[c], acc1[c]}; }
        __syncthreads();
        float* mod = (float*)(ws + WS_MOD);
        for (int e = tid; e < NCOND * 128; e += 512) { const int c = e >> 7, n = e & 127; float s = a.in[I_ADAB][l * MODW + n0 + n];
#pragma unroll
            for (int w = 0; w < 8; ++w) s += red[(w * NCOND + c) * 128 + n];
            mod[(size_t)(l * NCOND + c) * MODW + n0 + n] = s; }
        __syncthreads();
    }
    LAS float* scr = (LAS float*)(lds + wave * 16384);
    const int gw = blockIdx.x * 8 + wave, NGW = G * 8;
    constexpr int NIT = 28672;
    for (int it = gw; it < NIT; it += NGW) {
        int r = it;
#define TR(cnt, W, K, N, WT, mode) if (r < (cnt)) { transpose_item((W), (K), (N), (WT), (mode), scr, r, lane); continue; } r -= (cnt);
        TR(2048, a.in[I_AWIN], D, 4096, (bf16*)(ws + WS_WA_IN), 0)
        TR(2048, a.in[I_AWIN] + (size_t)D * 4096, D, 4096, (bf16*)(ws + WS_WA_IN + 8 * MiB), 0)
        TR(1024, a.in[I_AWOUT], AH, D, (bf16*)(ws + WS_WA_OUT), 0)
        TR(1024, a.in[I_AWOUT] + (size_t)AH * D, AH, D, (bf16*)(ws + WS_WA_OUT + 4 * MiB), 0)
        TR(1536, a.in[I_BWQKV], D, 3072, (bf16*)(ws + WS_WB_QKV), 1)
        TR(512, a.in[I_BWO], D, D, (bf16*)(ws + WS_WB_O), 0)
        TR(1536, a.in[I_CWIN], D, 3072, (bf16*)(ws + WS_WC_IN), 2)
        TR(512, a.in[I_CWOUT], D, D, (bf16*)(ws + WS_WC_OUT), 0)
        { const int l = r >> 11; if (l < 4) { transpose_item(a.in[I_FW1] + (size_t)l * D * FF, D, FF, (bf16*)(ws + WS_WF1 + (size_t)l * 8 * MiB), 0, scr, r & 2047, lane); continue; } r -= 8192; }
        { const int l = r >> 11; if (l < 4) { transpose_item(a.in[I_FW2] + (size_t)l * D * FF, FF, D, (bf16*)(ws + WS_WF2 + (size_t)l * 8 * MiB), 0, scr, r & 2047, lane); continue; } r -= 8192; }
        { const int b = r >> 8; transpose_item(a.in[I_CV] + (size_t)b * 512 * D, 512, D, (bf16*)(ws + WS_CVT) + (size_t)b * D * 512, 0, scr, r & 255, lane); }
#undef TR
    }
    { const f32x4* src = (const f32x4*)a.in[I_CK]; u32x4* dst = (u32x4*)(ws + WS_CKB);
      for (int e = blockIdx.x * 512 + tid; e < 8 * 512 * D / 8; e += G * 512) { const f32x4 v0 = src[2 * e], v1 = src[2 * e + 1];
          u32x4 w; w.x = cvt_pk_bf16(v0[0], v0[1]); w.y = cvt_pk_bf16(v0[2], v0[3]); w.z = cvt_pk_bf16(v1[0], v1[1]); w.w = cvt_pk_bf16(v1[2], v1[3]); dst[e] = w; } }
}
__device__ __forceinline__ void norm_phase(const Args& a, int l, int which, bool first, int lane, int wave, int G) {
    const float* g = a.in[I_NORMG] + (size_t)(l * 2 + which) * D;
    const float* mod = (const float*)(a.ws + WS_MOD) + (size_t)l * NCOND * MODW + which * 3 * D;
    bf16* H = (bf16*)(a.ws + WS_H);
    f32x4 gv[4];
#pragma unroll
    for (int j = 0; j < 4; ++j) gv[j] = *((const f32x4*)g + lane + 64 * j);
    for (int m = blockIdx.x * 8 + wave; m < T; m += G * 8) {
        const float* xr = first ? (m < TP ? a.in[I_XP] + (size_t)m * D : a.in[I_XS] + (size_t)(m - TP) * D) : a.out + (size_t)m * D;
        const float* mp = mod + (size_t)cond_of_row(m) * MODW;
        f32x4 v[4]; float s = 0.f;
#pragma unroll
        for (int j = 0; j < 4; ++j) { v[j] = *((const f32x4*)xr + lane + 64 * j); s += (v[j][0] * v[j][0] + v[j][1] * v[j][1]) + (v[j][2] * v[j][2] + v[j][3] * v[j][3]); }
        if (first) {
#pragma unroll
            for (int j = 0; j < 4; ++j) *((f32x4*)(a.out + (size_t)m * D) + lane + 64 * j) = v[j]; }
        const float rstd = __builtin_amdgcn_rsqf(wave_sum(s) * (1.0f / D) + EPS);
        u32x2* o8 = (u32x2*)(H + (size_t)m * D) + lane;
#pragma unroll
        for (int j = 0; j < 4; ++j) { const f32x4 sh = *((const f32x4*)mp + lane + 64 * j), scl = *((const f32x4*)(mp + D) + lane + 64 * j);
            const f32x4 y = (v[j] * rstd * gv[j]) * (scl + 1.0f) + sh;
            u32x2 w; w.x = cvt_pk_bf16(y[0], y[1]); w.y = cvt_pk_bf16(y[2], y[3]); o8[64 * j] = w; }
    }
}
#define MFMA32(a, b, c) __builtin_amdgcn_mfma_f32_32x32x16_bf16((a), (b), (c), 0, 0, 0)
__device__ __forceinline__ void gating_phase(const Args& a, int j, LAS unsigned char* lds, int tid, int lane, int wave, int G) {
    const bf16* U = (const bf16*)(a.ws + WS_BUF1); const bf16* VT = U + (size_t)T * AH; bf16* Aout = (bf16*)(a.ws + WS_BUF2);
    const float* part = (const float*)(a.ws + WS_PART);
    const float* wsm = a.in[I_AWS] + (size_t)j * 8 * 128 * 128; const float* bsm = a.in[I_ABS] + (size_t)j * 8 * 128; const float* gain = a.in[I_AVG] + (size_t)j * AH;
    LAS unsigned char* Al = lds;
    LAS float* rq = (LAS float*)(lds + 36864);
    LAS float* bsl = (LAS float*)(lds + 36864 + 512);
    const int l31 = lane & 31, hf = lane >> 5;
    for (int unit = blockIdx.x; unit < 768; unit += G) {
        const int chunk = unit >> 3, g = unit & 7, t0 = chunk * 128;
        if (tid < 128) { const f32x4* pp = (const f32x4*)(part + (size_t)(t0 + tid) * 16); const f32x4 p0 = pp[0], p1 = pp[1], p2 = pp[2], p3 = pp[3];
            const float s = ((p0[0] + p0[1]) + (p0[2] + p0[3])) + ((p1[0] + p1[1]) + (p1[2] + p1[3])) + ((p2[0] + p2[1]) + (p2[2] + p2[3])) + ((p3[0] + p3[1]) + (p3[2] + p3[3]));
            rq[tid] = __builtin_amdgcn_rsqf(s * (1.0f / AH) + EPS); bsl[tid] = bsm[g * 128 + tid]; }
        __syncthreads();
        { const int p = tid >> 2, q0 = (tid & 3) * 32; const float* src = wsm + ((size_t)g * 128 + p) * 128 + q0;
#pragma unroll
          for (int c = 0; c < 4; ++c) { const f32x4 w0 = *(const f32x4*)(src + 8 * c), w1 = *(const f32x4*)(src + 8 * c + 4); const f32x4 r0 = *(const LAS f32x4*)(rq + q0 + 8 * c), r1 = *(const LAS f32x4*)(rq + q0 + 8 * c + 4);
              u32x4 w; w.x = cvt_pk_bf16(w0[0] * r0[0], w0[1] * r0[1]); w.y = cvt_pk_bf16(w0[2] * r0[2], w0[3] * r0[3]); w.z = cvt_pk_bf16(w1[0] * r1[0], w1[1] * r1[1]); w.w = cvt_pk_bf16(w1[2] * r1[2], w1[3] * r1[3]);
              *(LAS u32x4*)(Al + p * 272 + (q0 + 8 * c) * 2) = w; } }
        __syncthreads();
        const int ch = g * 256 + wave * 32 + l31;
        const bf16* vp = VT + (size_t)ch * T + t0 + 8 * hf;
        bf16x8 bfr[8];
#pragma unroll
        for (int ks = 0; ks < 8; ++ks) bfr[ks] = *(const bf16x8*)(vp + 16 * ks);
        f32x16 acc[4];
#pragma unroll
        for (int mt = 0; mt < 4; ++mt) {
#pragma unroll
            for (int i = 0; i < 16; ++i) acc[mt][i] = 0.f;
#pragma unroll
            for (int ks = 0; ks < 8; ++ks) { const bf16x8 af = *(const LAS bf16x8*)(Al + (32 * mt + l31) * 272 + (16 * ks + 8 * hf) * 2); acc[mt] = MFMA32(af, bfr[ks], acc[mt]); }
        }
        const float gn = gain[ch];
#pragma unroll
        for (int mt = 0; mt < 4; ++mt)
#pragma unroll
            for (int i = 0; i < 16; ++i) { const int p = 32 * mt + 8 * (i >> 2) + 4 * hf + (i & 3); const size_t off = (size_t)(t0 + p) * AH + ch;
                const float s = acc[mt][i] * gn + bsl[p]; const float uu = bf2f(U[off]);
                Aout[off] = (bf16)(cvt_pk_bf16(uu * s, 0.f) & 0xffffu); }
        __syncthreads();
    }
}
__device__ __forceinline__ void conv_phase(const Args& a, int j, int lane, int wave, int G) {
    const bf16* BG = (const bf16*)(a.ws + WS_BUF1); const bf16* Z = BG + (size_t)T * D; bf16* A2 = (bf16*)(a.ws + WS_BUF2);
    const float* cw = a.in[I_CCW] + (size_t)j * 3 * D; const float* cb = a.in[I_CCB] + (size_t)j * D;
    for (int m = blockIdx.x * 8 + wave; m < T; m += G * 8) {
        const int tpos = m < TP ? (m & 255) : ((m - TP) & 1023), L = m < TP ? 256 : 1024;
        const bool hasp = tpos > 0, hasn = tpos < L - 1;
#pragma unroll
        for (int hh = 0; hh < 2; ++hh) { const int ch = 8 * lane + 512 * hh;
            const bf16x8 zc = *(const bf16x8*)(Z + (size_t)m * D + ch), bgv = *(const bf16x8*)(BG + (size_t)m * D + ch);
            bf16x8 zp = zc, zn = zc; if (hasp) zp = *(const bf16x8*)(Z + (size_t)(m - 1) * D + ch); if (hasn) zn = *(const bf16x8*)(Z + (size_t)(m + 1) * D + ch);
            float r[8];
#pragma unroll
            for (int e = 0; e < 8; ++e) { float v = cb[ch + e] + bf2f((unsigned short)zc[e]) * cw[D + ch + e];
                if (hasp) v += bf2f((unsigned short)zp[e]) * cw[ch + e]; if (hasn) v += bf2f((unsigned short)zn[e]) * cw[2 * D + ch + e];
                r[e] = v * bf2f((unsigned short)bgv[e]); }
            u32x4 w; w.x = cvt_pk_bf16(r[0], r[1]); w.y = cvt_pk_bf16(r[2], r[3]); w.z = cvt_pk_bf16(r[4], r[5]); w.w = cvt_pk_bf16(r[6], r[7]);
            *(u32x4*)(A2 + (size_t)m * D + ch) = w; }
    }
}
template <bool LOCAL>
__device__ __forceinline__ void attn_tile(const bf16x8 (&qf)[4], const bf16* kp, const bf16* vp, size_t vpitch, f32x16& o0, f32x16& o1, float& mrun, float& lsum,
                                          const LAS float* rp, int ck0, int cq, int cs) {
    const bf16x8 k0 = *(const bf16x8*)(kp), k1 = *(const bf16x8*)(kp + 16), k2 = *(const bf16x8*)(kp + 32), k3 = *(const bf16x8*)(kp + 48);
    const bf16* vp1 = vp + 32 * vpitch;
    const s16x4 a00 = *(const s16x4*)(vp), a01 = *(const s16x4*)(vp + 8), a02 = *(const s16x4*)(vp + 16), a03 = *(const s16x4*)(vp + 24);
    const s16x4 a10 = *(const s16x4*)(vp1), a11 = *(const s16x4*)(vp1 + 8), a12 = *(const s16x4*)(vp1 + 16), a13 = *(const s16x4*)(vp1 + 24);
    f32x16 s;
#pragma unroll
    for (int i = 0; i < 16; ++i) s[i] = 0.f;
    s = MFMA32(k0, qf[0], s); s = MFMA32(k1, qf[1], s); s = MFMA32(k2, qf[2], s); s = MFMA32(k3, qf[3], s);
    if (LOCAL) {
#pragma unroll
        for (int i = 0; i < 16; ++i) { const int ck = ck0 + 8 * (i >> 2) + (i & 3); const bool ok = (ck >= cs) && (ck < cs + 16);
            int idx = ck - cq + 15; idx = idx < 0 ? 0 : (idx > 30 ? 30 : idx);
            s[i] = ok ? s[i] + rp[idx] : -INFINITY; }
    }
    float mx = s[0];
#pragma unroll
    for (int i = 1; i < 16; ++i) mx = fmaxf(mx, s[i]);
    mx = fmaxf(mx, __shfl_xor(mx, 32));
    const float mn = fmaxf(mrun, mx), sc = __builtin_amdgcn_exp2f(mrun - mn); mrun = mn;
    float ps = 0.f;
#pragma unroll
    for (int i = 0; i < 16; ++i) { s[i] = __builtin_amdgcn_exp2f(s[i] - mn); ps += s[i]; }
    lsum = lsum * sc + ps; o0 *= sc; o1 *= sc;
    bf16x8 pb0, pb1;
    { u32x4 w; w.x = cvt_pk_bf16(s[0], s[1]); w.y = cvt_pk_bf16(s[2], s[3]); w.z = cvt_pk_bf16(s[4], s[5]); w.w = cvt_pk_bf16(s[6], s[7]); pb0 = __builtin_bit_cast(bf16x8, w);
      w.x = cvt_pk_bf16(s[8], s[9]); w.y = cvt_pk_bf16(s[10], s[11]); w.z = cvt_pk_bf16(s[12], s[13]); w.w = cvt_pk_bf16(s[14], s[15]); pb1 = __builtin_bit_cast(bf16x8, w); }
    o0 = MFMA32(__builtin_shufflevector(a00, a01, 0, 1, 2, 3, 4, 5, 6, 7), pb0, o0); o0 = MFMA32(__builtin_shufflevector(a02, a03, 0, 1, 2, 3, 4, 5, 6, 7), pb1, o0);
    o1 = MFMA32(__builtin_shufflevector(a10, a11, 0, 1, 2, 3, 4, 5, 6, 7), pb0, o1); o1 = MFMA32(__builtin_shufflevector(a12, a13, 0, 1, 2, 3, 4, 5, 6, 7), pb1, o1);
}
__device__ __forceinline__ void attn_phase(const Args& a, LAS unsigned char* lds, int tid, int lane, int wave, int G) {
    const bf16* Q = (const bf16*)(a.ws + WS_BUF1); const bf16* Kb = Q + (size_t)T * D; const bf16* VT = Kb + (size_t)T * D;
    const bf16* CKB = (const bf16*)(a.ws + WS_CKB); const bf16* CVT = (const bf16*)(a.ws + WS_CVT);
    bf16* O = (bf16*)(a.ws + WS_BUF2);
    LAS float* rpl = (LAS float*)lds;
    const int l31 = lane & 31, hf = lane >> 5;
    { float* nck = a.out + (size_t)T * D; float* ncv = nck + (size_t)TP * D;
      for (int e = blockIdx.x * 512 + tid; e < TP * D / 8; e += G * 512) { const bf16x8 v = *((const bf16x8*)Kb + e); f32x4 lo, hi;
#pragma unroll
          for (int i = 0; i < 4; ++i) { lo[i] = bf2f((unsigned short)v[i]); hi[i] = bf2f((unsigned short)v[4 + i]); }
          *((f32x4*)nck + 2 * e) = lo; *((f32x4*)nck + 2 * e + 1) = hi; }
      LAS float* scr = (LAS float*)(lds + 2048 + wave * 8704);
      for (int item = blockIdx.x * 8 + wave; item < 2048; item += G * 8) { const int ch0 = (item >> 6) * 32, tok0 = (item & 63) * 64;
#pragma unroll 4
          for (int i = 0; i < 16; ++i) { const int cr = 2 * i + hf; const unsigned w = *(const unsigned*)(VT + (size_t)(ch0 + cr) * T + tok0 + 2 * l31);
              scr[(2 * l31) * 33 + cr] = __uint_as_float(w << 16); scr[(2 * l31 + 1) * 33 + cr] = __uint_as_float(w & 0xffff0000u); }
          LDS_WAIT(); asm volatile("" ::: "memory");
#pragma unroll 4
          for (int i = 0; i < 32; ++i) { const int tr = 2 * i + hf; ncv[(size_t)(tok0 + tr) * D + ch0 + l31] = scr[tr * 33 + l31]; }
          LDS_WAIT(); asm volatile("" ::: "memory"); } }
    for (int unit = blockIdx.x; unit < 768; unit += G) {
        int qrow, h;
        f32x16 o0, o1;
#pragma unroll
        for (int i = 0; i < 16; ++i) { o0[i] = 0.f; o1[i] = 0.f; }
        float mrun = -1e30f, lsum = 0.f;
        bf16x8 qf[4];
        if (unit < 512) {
            const int b = unit >> 6; h = (unit >> 2) & 15; const int r = 4 * (unit & 3) + (wave >> 1), half = wave & 1;
            __syncthreads();
            if (tid < 465) rpl[tid] = a.in[I_RPB][h * 465 + tid] * LOG2E;
            __syncthreads();
            const int tb = TP + b * 1024;
            qrow = tb + r * 64 + 32 * half + l31;
            const bf16* qp = Q + (size_t)qrow * D + h * 64 + 8 * hf;
#pragma unroll
            for (int ks = 0; ks < 4; ++ks) qf[ks] = *(const bf16x8*)(qp + 16 * ks);
            const bf16* kp = CKB + ((size_t)b * 512 + l31) * D + h * 64 + 8 * hf;
            const bf16* vp = CVT + ((size_t)b * D + h * 64 + l31) * 512 + 4 * hf;
            for (int t = 0; t < 16; ++t) attn_tile<false>(qf, kp + (size_t)t * 32 * D, vp + t * 32, 512, o0, o1, mrun, lsum, rpl, 0, 0, 0);
            int start = r - 4; start = start < 0 ? 0 : (start > 8 ? 8 : start);
            const int cq = 32 * half + l31; int cs = cq - 8; cs = cs < 0 ? 0 : (cs > 48 ? 48 : cs);
            for (int t = 0; t < 16; ++t) { const int rr = start + (t >> 1), kh = t & 1; const int tok0 = tb + rr * 64 + 32 * kh;
                attn_tile<true>(qf, Kb + (size_t)(tok0 + l31) * D + h * 64 + 8 * hf, VT + (size_t)(h * 64 + l31) * T + tok0 + 4 * hf, T, o0, o1, mrun, lsum, rpl + (rr - r + 7) * 31, 32 * kh + 4 * hf, cq, cs); }
        } else {
            const int b = (unit - 512) >> 4; h = (unit - 512) & 15;
            qrow = b * 256 + 32 * wave + l31;
            const bf16* qp = Q + (size_t)qrow * D + h * 64 + 8 * hf;
#pragma unroll
            for (int ks = 0; ks < 4; ++ks) qf[ks] = *(const bf16x8*)(qp + 16 * ks);
            for (int t = 0; t < 8; ++t) { const int tok0 = b * 256 + 32 * t;
                attn_tile<false>(qf, Kb + (size_t)(tok0 + l31) * D + h * 64 + 8 * hf, VT + (size_t)(h * 64 + l31) * T + tok0 + 4 * hf, T, o0, o1, mrun, lsum, rpl, 0, 0, 0); }
        }
        const float inv = 1.0f / (lsum + __shfl_xor(lsum, 32));
        bf16* op = O + (size_t)qrow * D + h * 64 + 4 * hf;
#pragma unroll
        for (int b4 = 0; b4 < 4; ++b4) {
            u32x2 w; w.x = cvt_pk_bf16(o0[4 * b4] * inv, o0[4 * b4 + 1] * inv); w.y = cvt_pk_bf16(o0[4 * b4 + 2] * inv, o0[4 * b4 + 3] * inv); *(u32x2*)(op + 8 * b4) = w;
            w.x = cvt_pk_bf16(o1[4 * b4] * inv, o1[4 * b4 + 1] * inv); w.y = cvt_pk_bf16(o1[4 * b4 + 2] * inv, o1[4 * b4 + 3] * inv); *(u32x2*)(op + 32 + 8 * b4) = w; }
    }
}
#define XB_TMO      128
#define XB_XCNT(j)  (256  + 64 * (j))
#define XB_XSUB(j)  (1280 + 64 * (j))
#define XB_XGEN(j)  (2304 + 64 * (j))
#define XB_TOP      3328
#define XB_TOPGEN   3392
#define XCD_BAR_WORDS 3456
#define XB_SPIN_CAP (1u << 18)

__device__ __forceinline__ unsigned xb_ld(unsigned* p)              { return __hip_atomic_load(p, __ATOMIC_RELAXED, __HIP_MEMORY_SCOPE_AGENT); }
__device__ __forceinline__ unsigned xb_add(unsigned* p, unsigned v) { return __hip_atomic_fetch_add(p, v, __ATOMIC_RELAXED, __HIP_MEMORY_SCOPE_AGENT); }
__device__ __forceinline__ unsigned xb_xcc_id() { return (unsigned)__builtin_amdgcn_s_getreg((3 << 11) | 20) & 0xFu; }
#define XB_SPIN(cond, bar) do { unsigned _sp = 0; while (cond) { __builtin_amdgcn_s_sleep(1); \
    if ((++_sp & 255u) == 0u) { if (xb_ld(&(bar)[XB_TMO])) break; if (_sp > XB_SPIN_CAP) { atomicAdd(&(bar)[XB_TMO], 1u); break; } } } } while (0)

struct XcdBarrier {
    unsigned* bar; unsigned x;
    volatile LAS unsigned* st;
};

__device__ __forceinline__ XcdBarrier xcd_barrier_post(unsigned* bar, volatile LAS unsigned* st) {
    XcdBarrier b; b.bar = bar; b.x = xb_xcc_id(); b.st = st;
    if (threadIdx.x == 0) (void)xb_add(&bar[XB_XCNT(b.x)], 1u);
    return b;
}
__device__ __forceinline__ void xcd_barrier_complete(unsigned* bar, unsigned x, unsigned& nloc, unsigned& nx) {
    const unsigned G = gridDim.x * gridDim.y * gridDim.z;
    unsigned sum, cnt, mine, sp = 0u;
    for (;;) {
        sum = 0u; cnt = 0u; mine = 0u;
#pragma unroll
        for (unsigned j = 0; j < 16; ++j) { const unsigned c = xb_ld(&bar[XB_XCNT(j)]); sum += c; cnt += (c > 0u) ? 1u : 0u; mine = (j == x) ? c : mine; }
        if (sum == G) break;
        __builtin_amdgcn_s_sleep(1);
        if ((++sp & 255u) == 0u) { if (xb_ld(&bar[XB_TMO])) break; if (sp > XB_SPIN_CAP) { atomicAdd(&bar[XB_TMO], 1u); break; } }
    }
    nloc = mine > 0u ? mine : 1u; nx = cnt > 0u ? cnt : 1u;
}

__device__ __forceinline__ void xcd_barrier(const XcdBarrier& b) {
    asm volatile("s_waitcnt vmcnt(0)" ::: "memory");
    __syncthreads();
    if (threadIdx.x == 0) {
        unsigned* bar = b.bar;
        __builtin_amdgcn_s_waitcnt(0);
        unsigned nloc = b.st[0], nx = b.st[1];
        if (nloc == 0u) { xcd_barrier_complete(bar, b.x, nloc, nx); b.st[0] = nloc; b.st[1] = nx; }
        const unsigned old = xb_add(&bar[XB_XSUB(b.x)], 1u);
        const unsigned gen = old / nloc;
        if (old + 1u == (gen + 1u) * nloc) {
            __builtin_amdgcn_fence(__ATOMIC_RELEASE, "agent");
            asm volatile("s_waitcnt vmcnt(0)" ::: "memory");
            const unsigned og = xb_add(&bar[XB_TOP], 1u);
            const unsigned tg = og / nx;
            if (og + 1u == (tg + 1u) * nx) xb_add(&bar[XB_TOPGEN], 1u);
            else XB_SPIN(xb_ld(&bar[XB_TOPGEN]) == tg, bar);
            __builtin_amdgcn_fence(__ATOMIC_ACQUIRE, "agent");
            xb_add(&bar[XB_XGEN(b.x)], 1u);
            asm volatile("s_waitcnt vmcnt(0)" ::: "memory");
        } else {
            XB_SPIN(xb_ld(&bar[XB_XGEN(b.x)]) == gen, bar);
            __builtin_amdgcn_fence(__ATOMIC_ACQUIRE, "agent");
            asm volatile("s_waitcnt vmcnt(0)" ::: "memory");
        }
    }
    __syncthreads();
}


struct EpiU {
    static constexpr bool PERM = true, AFTER_DRAIN = false;
    int type; int ldc; bf16* b0; bf16* b1; const float* f0; const float* f1; float* o0;
    __device__ __forceinline__ void operator()(ACC_T, const pg8::Unit& u, int wr_, int wc_, int fr_, int fq_) const {
        int wr = wr_, wc = wc_, fr = fr_, fq = fq_; asm volatile("" : "+s"(wr), "+s"(wc), "+v"(fr), "+v"(fq));
        switch (type) {
            case 0: { EpiAct<1> E{b0, ldc}; E(acc, u, wr, wc, fr, fq); } break;
            case 1: { EpiAct<2> E{b0, ldc}; E(acc, u, wr, wc, fr, fq); } break;
            case 2: { EpiVT E{b0, o0}; E(acc, u, wr, wc, fr, fq); } break;
            case 3: { EpiRes E{o0, f0}; E(acc, u, wr, wc, fr, fq); } break;
            case 4: { EpiQK E{b0, b1, f0, f1, o0}; E(acc, u, wr, wc, fr, fq); } break;
            case 5: { EpiVTattn E{b0, o0}; E(acc, u, wr, wc, fr, fq); } break;
            default: { EpiConvIn E{b0, b1}; E(acc, u, wr, wc, fr, fq); } break;
        }
    }
};
#ifndef DUP
#define DUP 0
#endif
constexpr size_t WS_SCR = 296 * MiB;
#ifndef EN
#define EN 0xffff
#endif
__global__ void __launch_bounds__(512, 2) fwd_kernel(Args a) {
    extern __shared__ __attribute__((aligned(16))) unsigned char lds_raw[];
    LAS unsigned char* lds = (LAS unsigned char*)lds_raw;
    cg::grid_group grid = cg::this_grid();
    const int G = gridDim.x;
    unsigned char* ws = a.ws;
    if (threadIdx.x < 16) ((LAS unsigned*)(lds + 131072 + 64))[threadIdx.x] = 0u;
    if (blockIdx.x == 0) for (int i = threadIdx.x; i < XCD_BAR_WORDS; i += 512) ((unsigned*)(ws + WS_CTL))[i] = 0u;
    __syncthreads();
    XcdBarrier xb; xb.bar = (unsigned*)(ws + WS_CTL); xb.x = 0; xb.st = (volatile LAS unsigned*)(lds + 131072 + 64);
    for (int ph = a.ph_lo; ph < a.ph_hi; ++ph) {
        const int sdup = ph == 0 ? 0 : 1 + (ph - 1) % 7;
        int nrep = ((DUP >> sdup) & 1) ? 2 : 1; asm volatile("" : "+s"(nrep));
#pragma clang loop unroll(disable)
        for (int rep = 0; rep < nrep; ++rep) {
        int tid = threadIdx.x; asm volatile("" : "+v"(tid));
        const int lane = tid & 63, wave = __builtin_amdgcn_readfirstlane(tid >> 6);
        bf16* H = (bf16*)(ws + WS_H); bf16* B1 = (bf16*)(ws + WS_BUF1); bf16* B2 = (bf16*)(ws + WS_BUF2);
        if (ph == 0) { if (EN & 1) p0_prologue(a, lds, tid, lane, wave, G); }
        else {
            const int l = (ph - 1) / 7, s = (ph - 1) % 7, kind = l % 3, j = l / 3;
            const float* modl = (const float*)(ws + WS_MOD) + (size_t)l * NCOND * MODW;
            if (s == 0 || s == 4) { if (EN & 2) norm_phase(a, l, s == 4, ph == 1, lane, wave, G); }
            else if (s == 2) {
                if (kind == 0) { if (EN & 512) gating_phase(a, j, lds, tid, lane, wave, G); }
                else if (kind == 1) { if (EN & 1024) attn_phase(a, lds, tid, lane, wave, G); }
                else { if (EN & 2048) conv_phase(a, j, lane, wave, G); }
            } else if (EN & 4) {
                for (int gi = 0; gi < 2; ++gi) {
                    const bf16* A = H; const bf16* Bt; int M = T, N, K = D, shift = 0; EpiU E{};
                    if (s == 5) { if (gi) break; Bt = (const bf16*)(ws + WS_WF1 + (size_t)l * 8 * MiB); N = FF; E.type = 1; E.b0 = B1; E.ldc = FF; }
                    else if (s == 6) { if (gi) break; A = B1; Bt = (const bf16*)(ws + WS_WF2 + (size_t)l * 8 * MiB); N = D; K = FF; E.type = 3; E.o0 = (nrep == 2 && rep == 0) ? (float*)(ws + WS_SCR) : a.out; E.f0 = modl + 5 * D; }
                    else if (s == 3) { if (gi) break; A = B2; Bt = (const bf16*)(ws + (kind == 0 ? WS_WA_OUT + (size_t)j * 4 * MiB : (kind == 1 ? WS_WB_O : WS_WC_OUT))); N = D; K = kind == 0 ? AH : D; E.type = 3; E.o0 = (nrep == 2 && rep == 0) ? (float*)(ws + WS_SCR) : a.out; E.f0 = modl + 2 * D; }
                    else if (kind == 0) { const bf16* W = (const bf16*)(ws + WS_WA_IN + (size_t)j * 8 * MiB);
                        if (gi == 0) { Bt = W; N = AH; E.type = 0; E.b0 = B1; E.ldc = AH; }
                        else { A = W + (size_t)AH * D; Bt = H; M = AH; N = T; shift = 128; E.type = 2; E.b0 = B1 + (size_t)T * AH; E.o0 = (float*)(ws + WS_PART); } }
                    else if (kind == 1) { const bf16* W = (const bf16*)(ws + WS_WB_QKV);
                        if (gi == 0) { Bt = W; N = 2048; E.type = 4; E.b0 = B1; E.b1 = B1 + (size_t)T * D; E.f0 = a.in[I_BQG] + j * 64; E.f1 = a.in[I_BKG] + j * 64; E.o0 = a.out + (size_t)T * D; }
                        else { A = W + (size_t)2048 * D; Bt = H; M = D; N = T; shift = 128; E.type = 5; E.b0 = B1 + (size_t)2 * T * D; E.o0 = a.out + (size_t)T * D + (size_t)TP * D; } }
                    else { if (gi) break; Bt = (const bf16*)(ws + WS_WC_IN); N = 3072; E.type = 6; E.b0 = B1; E.b1 = B1 + (size_t)T * D; }
                    pg8::Gemm g{A, Bt, M, N, K}; pg8::StaticOrder S; S.init(M, N, G, (int)((blockIdx.x + shift) % G));
                    pg8::gemm_phase<EpiU, pg8::StaticOrder, true, true>(lds, g, S, E);
                }
            }
        }
        }
        if (ph + 1 < a.ph_hi) {
            if (ph == a.ph_lo) { grid.sync(); xb = xcd_barrier_post((unsigned*)(ws + WS_CTL), (volatile LAS unsigned*)(lds + 131072 + 64)); }
            else { xcd_barrier(xb); if (DUP & 256) xcd_barrier(xb); }
        }
    }
}

#ifndef N_LAUNCH_MODE
#define N_LAUNCH_MODE 1
#endif
extern "C" void kernel_launch(void* const* d_in, const int* in_sizes, int n_in, void* d_out, int out_size, void* d_ws, size_t ws_size, hipStream_t stream) {
    static int grid = 0;
    if (grid == 0) {
        if (n_in != 25 || ws_size < WS_END) { fprintf(stderr, "kernel_launch: unexpected n_in %d or ws_size %zu\n", n_in, ws_size); grid = -1; return; }
        int dev = 0, cus = 0, per_cu = 0;
        hipGetDevice(&dev); hipDeviceGetAttribute(&cus, hipDeviceAttributeMultiprocessorCount, dev);
        if (hipFuncSetAttribute((const void*)fwd_kernel, hipFuncAttributeMaxDynamicSharedMemorySize, LDS_BYTES) != hipSuccess) { fprintf(stderr, "kernel_launch: hipFuncSetAttribute failed\n"); grid = -1; return; }
        if (hipOccupancyMaxActiveBlocksPerMultiprocessor(&per_cu, (const void*)fwd_kernel, 512, LDS_BYTES) != hipSuccess || per_cu < 1) { fprintf(stderr, "kernel_launch: occupancy query says %d\n", per_cu); per_cu = 1; }
        (void)hipGetLastError();
        grid = cus * per_cu;
        fprintf(stderr, "kernel_launch: grid %d (cus %d x %d)\n", grid, cus, per_cu);
    }
    if (grid < 0) return;
    Args a{};
    for (int i = 0; i < 25; ++i) a.in[i] = (const float*)d_in[i];
    a.out = (float*)d_out; a.ws = (unsigned char*)d_ws;
#if N_LAUNCH_MODE == 1
    a.ph_lo = 0; a.ph_hi = NPHASE;
    void* args[] = {&a};
    hipError_t e = hipLaunchCooperativeKernel((const void*)fwd_kernel, dim3(grid), dim3(512), args, LDS_BYTES, stream);
    if (e != hipSuccess) fprintf(stderr, "cooperative launch failed: %s (grid %d)\n", hipGetErrorString(e), grid);
#else
    for (int ph = 0; ph < NPHASE; ++ph) { a.ph_lo = ph; a.ph_hi = ph + 1; hipLaunchKernelGGL(fwd_kernel, dim3(grid), dim3(512), LDS_BYTES, stream, a); }
#endif
}
```

```cpp
#include <hip/hip_runtime.h>
#include <hip/hip_cooperative_groups.h>
#include <cstdio>
#include <cstdint>
namespace cg = cooperative_groups;

namespace pg8 {
#define PG8_LAS __attribute__((address_space(3)))
typedef unsigned short bf16_t;
typedef short bf16x8 __attribute__((ext_vector_type(8)));
typedef float f32x4 __attribute__((ext_vector_type(4)));
typedef unsigned u32x4 __attribute__((ext_vector_type(4)));
constexpr int BM = 256, BK = 64, HALF = 128, HTB = HALF * BK * 2  , STAGE_BYTES = 8 * HTB, NXCD = 8, WGM = 8;

__host__ __device__ __forceinline__ int lds_byte(int r, int c) { const int st = (r >> 4) * 2 + (c >> 5), rr = r & 15, cc = c & 31, ob = rr * 64 + cc * 2; return st * 1024 + (ob ^ (((ob >> 9) & 1) << 5)); }
__host__ __device__ __forceinline__ void stage_rc(int b, int& R, int& C) { const int st = b / 1024, sb = b % 1024, swz = sb ^ (((sb >> 9) & 1) << 5); R = (st >> 1) * 16 + swz / 64; C = (st & 1) * 32 + (swz % 64) / 2; }
__host__ __device__ __forceinline__ int perm32(int rho) { const int n = rho >> 4, i = rho & 15; return 8 * (i >> 2) + 4 * n + (i & 3); }

struct Unit { int pm, pn; };
struct Gemm { const bf16_t* A; const bf16_t* Bt; int M, N, K; };

struct StaticOrder {
    int nM, nN, nwg, G, c;
    __host__ __device__ void init(int M, int N, int G_, int c_) { nM = M / BM; nN = N / BM; nwg = nM * nN; G = G_; c = c_; }
    __host__ __device__ bool next(int i, Unit& u) const {
        const long L = (long)i * G + c; if (L >= nwg) return false;
        int wgid = (int)L; { const int q = nwg / NXCD, r = nwg % NXCD, xcd = wgid % NXCD, off = wgid / NXCD; wgid = (xcd < r ? xcd * (q + 1) : r * (q + 1) + (xcd - r) * q) + off; }
        const int nig = WGM * nN, gid = wgid / nig, fm = gid * WGM, gsz = (nM - fm) < WGM ? (nM - fm) : WGM;
        u.pm = fm + ((wgid % nig) % gsz); u.pn = (wgid % nig) / gsz; return true;
    }
    __device__ __forceinline__ void a_ready(const Unit&) const {}
    __device__ __forceinline__ void done(const Unit&) const {}
};

__device__ __forceinline__ unsigned cvt_pk_bf16(float lo, float hi) { unsigned r; asm volatile("v_cvt_pk_bf16_f32 %0, %1, %2" : "=v"(r) : "v"(lo), "v"(hi)); return r; }

template <class Epi, class Sched, bool ALIGN_EPI = false, bool SP2 = false>
__device__ __forceinline__ void gemm_phase(PG8_LAS unsigned char* lds, const Gemm g, const Sched& S, const Epi& E) {
    const int tid = threadIdx.x, wid = __builtin_amdgcn_readfirstlane(tid >> 6), lane = tid & 63, wr = wid >> 2, wc = wid & 3, fr = lane & 15, fq = lane >> 4;
    const int K = g.K, nt = K / BK;
    unsigned voffA[2], voffB[2];
#pragma unroll
    for (int i = 0; i < 2; ++i) { int R, C; stage_rc(tid * 16 + i * 8192, R, C); const int Rb = Epi::PERM ? ((R & ~31) + perm32(R & 31)) : R;
        voffA[i] = (unsigned)(R * K + C) * 2u; voffB[i] = (unsigned)(Rb * K + C) * 2u; }
    const size_t kstep = (size_t)(BK * 2);
    const size_t hstep = (size_t)HALF * K * 2;
    const size_t tstep = 2 * hstep;
    const unsigned ldsw = (unsigned)wid * 1024u;
    const int aoff = lds_byte(wr * 64 + fr, fq * 8), boff = lds_byte(wc * 32 + fr, fq * 8);
#define PG8_SA(b, h) (((b) * 2 + (h)) * HTB)
#define PG8_SB(b, h) ((4 + (b) * 2 + (h)) * HTB)
#define PG8_STAGE(bufoff, gbase, voff) do { _Pragma("unroll") for (int _i = 0; _i < 2; ++_i) \
        __builtin_amdgcn_global_load_lds((const unsigned*)((const char*)(gbase) + (voff)[_i]), (PG8_LAS unsigned*)(lds + (bufoff) + ldsw + _i * 8192), 16, 0, 0); } while (0)
#define PG8_LDA(dst, b, h) do { _Pragma("unroll") for (int m = 0; m < 4; ++m) _Pragma("unroll") for (int k = 0; k < 2; ++k) dst[m][k] = *(const PG8_LAS bf16x8*)(lds + PG8_SA(b, h) + aoff + m * 2048 + k * 1024); } while (0)
#define PG8_LDB(dst, b, h) do { _Pragma("unroll") for (int n = 0; n < 2; ++n) _Pragma("unroll") for (int k = 0; k < 2; ++k) dst[n][k] = *(const PG8_LAS bf16x8*)(lds + PG8_SB(b, h) + boff + n * 2048 + k * 1024); } while (0)
#define PG8_MMA(ai, bj, At, Bt) do { __builtin_amdgcn_s_setprio(1); _Pragma("unroll") for (int m = 0; m < 4; ++m) _Pragma("unroll") for (int n = 0; n < 2; ++n) _Pragma("unroll") for (int k = 0; k < 2; ++k) \
        acc[ai][bj][m][n] = __builtin_amdgcn_mfma_f32_16x16x32_bf16(Bt[n][k], At[m][k], acc[ai][bj][m][n], 0, 0, 0); __builtin_amdgcn_s_setprio(0); } while (0)
#define PG8_WAIT_V(n) asm volatile("s_waitcnt vmcnt(" #n ")" ::: "memory")
#define PG8_WAIT_L(n) asm volatile("s_waitcnt lgkmcnt(" #n ")" ::: "memory")
#define PG8_BAR __builtin_amdgcn_s_barrier()
#define PG8_SCHED __builtin_amdgcn_sched_barrier(0)
    Unit cur, nxt; int ui = 0;
    if (!S.next(0, cur)) return;
    f32x4 acc[2][2][4][2];
#pragma unroll
    for (int a = 0; a < 2; ++a)
#pragma unroll
        for (int b = 0; b < 2; ++b)
#pragma unroll
            for (int m = 0; m < 4; ++m)
#pragma unroll
                for (int n = 0; n < 2; ++n) acc[a][b][m][n] = (f32x4){0.f, 0.f, 0.f, 0.f};
    bf16x8 At[4][2], B0[2][2], B1[2][2];
    const char* cA = (const char*)g.A + (size_t)cur.pm * tstep; const char* cB = (const char*)g.Bt + (size_t)cur.pn * tstep;
    S.a_ready(cur);
    if constexpr (SP2) {
        PG8_STAGE(PG8_SB(0, 0), cB, voffB); PG8_STAGE(PG8_SB(0, 1), cB + hstep, voffB); PG8_STAGE(PG8_SA(0, 0), cA, voffA); PG8_STAGE(PG8_SA(0, 1), cA + hstep, voffA);
        if (wr == 1) PG8_BAR;
        PG8_WAIT_V(2); PG8_BAR;
        PG8_STAGE(PG8_SB(1, 0), cB + kstep, voffB); PG8_STAGE(PG8_SA(1, 0), cA + kstep, voffA); PG8_STAGE(PG8_SB(1, 1), cB + hstep + kstep, voffB);
        PG8_WAIT_V(6); PG8_BAR;
    } else {
        PG8_STAGE(PG8_SB(0, 0), cB, voffB); PG8_STAGE(PG8_SA(0, 0), cA, voffA); PG8_STAGE(PG8_SB(0, 1), cB + hstep, voffB); PG8_STAGE(PG8_SA(0, 1), cA + hstep, voffA);
        if (wr == 1) PG8_BAR;
        PG8_WAIT_V(4); PG8_BAR;
        PG8_STAGE(PG8_SB(1, 0), cB + kstep, voffB); PG8_STAGE(PG8_SA(1, 0), cA + kstep, voffA); PG8_STAGE(PG8_SB(1, 1), cB + hstep + kstep, voffB);
        PG8_WAIT_V(6); PG8_BAR;
    }
    for (;;) {
        const bool has_next = S.next(ui + 1, nxt);
        const char* nA = has_next ? (const char*)g.A + (size_t)nxt.pm * tstep : cA; const char* nB = has_next ? (const char*)g.Bt + (size_t)nxt.pn * tstep : cB;
        for (int t = 0; t < nt; t += 2) {
            const bool last = (t == nt - 2);
            const char* a1 = cA + (size_t)(t + 1) * kstep;
            const char* a2 = last ? nA : cA + (size_t)(t + 2) * kstep; const char* b2 = last ? nB : cB + (size_t)(t + 2) * kstep;
            const char* a3 = a2 + kstep; const char* b3 = b2 + kstep;
            if (last && has_next) S.a_ready(nxt);
            if constexpr (SP2) {
            PG8_LDB(B0, 0, 0); PG8_LDB(B1, 0, 1); PG8_SCHED; PG8_LDA(At, 0, 0); PG8_STAGE(PG8_SA(1, 1), a1 + hstep, voffA);
            PG8_WAIT_V(8); PG8_WAIT_L(0); PG8_BAR; PG8_MMA(0, 0, At, B0); PG8_MMA(0, 1, At, B1); PG8_BAR; PG8_SCHED;
            PG8_LDA(At, 0, 1); PG8_STAGE(PG8_SB(0, 0), b2, voffB); PG8_STAGE(PG8_SB(0, 1), b2 + hstep, voffB); PG8_STAGE(PG8_SA(0, 0), a2, voffA);
            PG8_WAIT_V(8); PG8_WAIT_L(0); PG8_BAR; PG8_MMA(1, 0, At, B0); PG8_MMA(1, 1, At, B1); PG8_BAR; PG8_SCHED;
            PG8_LDB(B0, 1, 0); PG8_LDB(B1, 1, 1); PG8_SCHED; PG8_LDA(At, 1, 0); PG8_STAGE(PG8_SA(0, 1), a2 + hstep, voffA);
            PG8_WAIT_V(8); PG8_WAIT_L(0); PG8_BAR; PG8_MMA(0, 0, At, B0); PG8_MMA(0, 1, At, B1); PG8_BAR; PG8_SCHED;
            PG8_LDA(At, 1, 1); PG8_STAGE(PG8_SB(1, 0), b3, voffB); PG8_STAGE(PG8_SB(1, 1), b3 + hstep, voffB); PG8_STAGE(PG8_SA(1, 0), a3, voffA);
            PG8_WAIT_V(8); PG8_WAIT_L(0); PG8_BAR; PG8_MMA(1, 0, At, B0); PG8_MMA(1, 1, At, B1); PG8_BAR; PG8_SCHED;
            } else {
            PG8_LDB(B0, 0, 0); PG8_SCHED; PG8_LDA(At, 0, 0); PG8_STAGE(PG8_SA(1, 1), a1 + hstep, voffA);
            PG8_WAIT_L(8); PG8_BAR; PG8_WAIT_L(0); PG8_MMA(0, 0, At, B0); PG8_BAR; PG8_SCHED;
            PG8_LDB(B1, 0, 1); PG8_STAGE(PG8_SB(0, 0), b2, voffB);
            PG8_BAR; PG8_WAIT_L(0); PG8_MMA(0, 1, At, B1); PG8_BAR;
            PG8_LDA(At, 0, 1); PG8_STAGE(PG8_SA(0, 0), a2, voffA);
            PG8_BAR; PG8_WAIT_L(0); PG8_MMA(1, 0, At, B0); PG8_BAR; PG8_SCHED;
            PG8_STAGE(PG8_SB(0, 1), b2 + hstep, voffB);
            PG8_WAIT_V(6); PG8_BAR; PG8_MMA(1, 1, At, B1); PG8_BAR;
            PG8_LDB(B0, 1, 0); PG8_SCHED; PG8_LDA(At, 1, 0); PG8_STAGE(PG8_SA(0, 1), a2 + hstep, voffA);
            PG8_WAIT_L(8); PG8_BAR; PG8_WAIT_L(0); PG8_MMA(0, 0, At, B0); PG8_BAR; PG8_SCHED;
            PG8_LDB(B1, 1, 1); PG8_STAGE(PG8_SB(1, 0), b3, voffB);
            PG8_BAR; PG8_WAIT_L(0); PG8_MMA(0, 1, At, B1); PG8_BAR;
            PG8_LDA(At, 1, 1); PG8_STAGE(PG8_SA(1, 0), a3, voffA);
            PG8_BAR; PG8_WAIT_L(0); PG8_MMA(1, 0, At, B0); PG8_BAR; PG8_SCHED;
            PG8_STAGE(PG8_SB(1, 1), b3 + hstep, voffB);
            PG8_WAIT_V(6); PG8_BAR; PG8_MMA(1, 1, At, B1); PG8_BAR;
            }
        }
        if constexpr (ALIGN_EPI) { if (wr == 0) PG8_BAR; }
        if constexpr (!Epi::AFTER_DRAIN) { E(acc, cur, wr, wc, fr, fq); S.done(cur); }
        if (!has_next) break;
#pragma unroll
        for (int a = 0; a < 2; ++a)
#pragma unroll
            for (int b = 0; b < 2; ++b)
#pragma unroll
                for (int m = 0; m < 4; ++m)
#pragma unroll
                    for (int n = 0; n < 2; ++n) acc[a][b][m][n] = (f32x4){0.f, 0.f, 0.f, 0.f};
        cur = nxt; cA = nA; cB = nB; ++ui;
        if constexpr (ALIGN_EPI) { if (wr == 1) PG8_BAR; }
    }
    PG8_WAIT_V(0);
    if constexpr (!ALIGN_EPI) { if (wr == 0) PG8_BAR; }
    PG8_BAR;
    if constexpr (Epi::AFTER_DRAIN) { E.fused(acc, cur, wr, wc, fr, fq, lds, wid, lane); S.done(cur); }
#undef PG8_SA
#undef PG8_SB
#undef PG8_STAGE
#undef PG8_LDA
#undef PG8_LDB
#undef PG8_MMA
#undef PG8_WAIT_V
#undef PG8_WAIT_L
#undef PG8_BAR
#undef PG8_SCHED
}
}
#define LAS __attribute__((address_space(3)))
typedef unsigned short bf16;
typedef float f32x4 __attribute__((ext_vector_type(4)));
typedef float f32x2 __attribute__((ext_vector_type(2)));
typedef float f32x16 __attribute__((ext_vector_type(16)));
typedef short bf16x8 __attribute__((ext_vector_type(8)));
typedef short s16x4 __attribute__((ext_vector_type(4)));
typedef unsigned u32x4 __attribute__((ext_vector_type(4)));
typedef unsigned u32x2 __attribute__((ext_vector_type(2)));

constexpr int D = 1024, TP = 4096, TS = 8192, T = 12288, FF = 4096, AH = 2048, NCOND = 9, MODW = 6144;
constexpr float EPS = 1e-6f, LOG2E = 1.4426950408889634f;
constexpr size_t MiB = 1u << 20;
constexpr size_t WS_CTL = 0, WS_MOD = 1 * MiB, WS_PART = 2 * MiB;
constexpr size_t WS_WA_IN = 4 * MiB, WS_WA_OUT = 20 * MiB, WS_WB_QKV = 28 * MiB, WS_WB_O = 34 * MiB, WS_WC_IN = 36 * MiB, WS_WC_OUT = 42 * MiB;
constexpr size_t WS_WF1 = 44 * MiB, WS_WF2 = 76 * MiB, WS_CKB = 108 * MiB, WS_CVT = 116 * MiB, WS_H = 124 * MiB, WS_BUF1 = 148 * MiB, WS_BUF2 = 244 * MiB, WS_END = 292 * MiB;
constexpr int LDS_BYTES = 147456;
constexpr int NPHASE = 29;

using pg8::cvt_pk_bf16;
__device__ __forceinline__ float bf2f(unsigned short b) { return __uint_as_float((unsigned)b << 16); }
__device__ __forceinline__ float gelu_tanh(float x) {
    const float t = x * x, w = x * (0.7978845608f + 0.0356774081f * t);
    const float e = __builtin_amdgcn_exp2f(-2.885390082f * w);
    return x * __builtin_amdgcn_rcpf(1.0f + e);
}
__device__ __forceinline__ int cond_of_tile(int pm) { return pm < 16 ? 8 : ((pm - 16) >> 2); }
__device__ __forceinline__ int cond_of_row(int m) { return m < TP ? 8 : ((m - TP) >> 10); }

typedef pg8::f32x4 af4;
#define ACC_T const pg8::f32x4 (&acc)[2][2][4][2]
template <int ACT> struct EpiAct {
    static constexpr bool PERM = true, AFTER_DRAIN = false;
    bf16* O; int ldc;
    __device__ __forceinline__ void operator()(ACC_T, const pg8::Unit& u, int wr, int wc, int fr, int fq) const {
        const int row0 = u.pm * 256 + wr * 64 + fr, col0 = u.pn * 256 + wc * 32 + 8 * fq;
#pragma unroll
        for (int ai = 0; ai < 2; ++ai)
#pragma unroll
            for (int m = 0; m < 4; ++m) { bf16* rowp = O + (size_t)(row0 + ai * 128 + m * 16) * ldc + col0;
#pragma unroll
                for (int bj = 0; bj < 2; ++bj) { af4 v0 = acc[ai][bj][m][0], v1 = acc[ai][bj][m][1];
                    if (ACT == 1) {
#pragma unroll
                        for (int i = 0; i < 4; ++i) { v0[i] = gelu_tanh(v0[i]); v1[i] = gelu_tanh(v1[i]); } }
                    if (ACT == 2) {
#pragma unroll
                        for (int i = 0; i < 4; ++i) { float a = fmaxf(v0[i], 0.f), b = fmaxf(v1[i], 0.f); v0[i] = a * a; v1[i] = b * b; } }
                    u32x4 w; w.x = cvt_pk_bf16(v0[0], v0[1]); w.y = cvt_pk_bf16(v0[2], v0[3]); w.z = cvt_pk_bf16(v1[0], v1[1]); w.w = cvt_pk_bf16(v1[2], v1[3]);
                    *(u32x4*)(rowp + bj * 128) = w; } }
    }
};
struct EpiVT {
    static constexpr bool PERM = true, AFTER_DRAIN = false;
    bf16* O; float* part;
    __device__ __forceinline__ void operator()(ACC_T, const pg8::Unit& u, int wr, int wc, int fr, int fq) const {
        const int row0 = u.pm * 256 + wr * 64 + fr, col0 = u.pn * 256 + wc * 32 + 8 * fq;
        float cs[2][2][4];
#pragma unroll
        for (int bj = 0; bj < 2; ++bj)
#pragma unroll
            for (int n = 0; n < 2; ++n)
#pragma unroll
                for (int i = 0; i < 4; ++i) cs[bj][n][i] = 0.f;
#pragma unroll
        for (int ai = 0; ai < 2; ++ai)
#pragma unroll
            for (int m = 0; m < 4; ++m) { bf16* rowp = O + (size_t)(row0 + ai * 128 + m * 16) * T + col0;
#pragma unroll
                for (int bj = 0; bj < 2; ++bj) { af4 v0 = acc[ai][bj][m][0], v1 = acc[ai][bj][m][1];
#pragma unroll
                    for (int i = 0; i < 4; ++i) { v0[i] = gelu_tanh(v0[i]); v1[i] = gelu_tanh(v1[i]); cs[bj][0][i] += v0[i] * v0[i]; cs[bj][1][i] += v1[i] * v1[i]; }
                    u32x4 w; w.x = cvt_pk_bf16(v0[0], v0[1]); w.y = cvt_pk_bf16(v0[2], v0[3]); w.z = cvt_pk_bf16(v1[0], v1[1]); w.w = cvt_pk_bf16(v1[2], v1[3]);
                    *(u32x4*)(rowp + bj * 128) = w; }
                asm volatile("" : "+v"(cs[0][0][0]), "+v"(cs[0][0][1]), "+v"(cs[0][0][2]), "+v"(cs[0][0][3]), "+v"(cs[0][1][0]), "+v"(cs[0][1][1]), "+v"(cs[0][1][2]), "+v"(cs[0][1][3]),
                             "+v"(cs[1][0][0]), "+v"(cs[1][0][1]), "+v"(cs[1][0][2]), "+v"(cs[1][0][3]), "+v"(cs[1][1][0]), "+v"(cs[1][1][1]), "+v"(cs[1][1][2]), "+v"(cs[1][1][3])); }
#pragma unroll
        for (int bj = 0; bj < 2; ++bj)
#pragma unroll
            for (int n = 0; n < 2; ++n)
#pragma unroll
                for (int i = 0; i < 4; ++i) { float s = cs[bj][n][i]; s += __shfl_xor(s, 1); s += __shfl_xor(s, 2); s += __shfl_xor(s, 4); s += __shfl_xor(s, 8);
                    if (fr == 0) part[(size_t)(col0 + bj * 128 + 4 * n + i) * 16 + u.pm * 2 + wr] = s; }
    }
};
struct EpiRes {
    static constexpr bool PERM = true, AFTER_DRAIN = false;
    float* x; const float* gate;
    __device__ __forceinline__ void operator()(ACC_T, const pg8::Unit& u, int wr, int wc, int fr, int fq) const {
        const int row0 = u.pm * 256 + wr * 64 + fr, col0 = u.pn * 256 + wc * 32 + 8 * fq;
        const float* gp = gate + (size_t)cond_of_tile(u.pm) * MODW + col0;
        f32x4 g[2][2];
#pragma unroll
        for (int bj = 0; bj < 2; ++bj) { g[bj][0] = *(const f32x4*)(gp + bj * 128); g[bj][1] = *(const f32x4*)(gp + bj * 128 + 4); }
#pragma unroll
        for (int ai = 0; ai < 2; ++ai)
#pragma unroll
            for (int m = 0; m < 4; ++m) { float* rowp = x + (size_t)(row0 + ai * 128 + m * 16) * D + col0;
#pragma unroll
                for (int bj = 0; bj < 2; ++bj) { f32x4 x0 = *(const f32x4*)(rowp + bj * 128), x1 = *(const f32x4*)(rowp + bj * 128 + 4);
                    x0 += g[bj][0] * acc[ai][bj][m][0]; x1 += g[bj][1] * acc[ai][bj][m][1];
                    *(f32x4*)(rowp + bj * 128) = x0; *(f32x4*)(rowp + bj * 128 + 4) = x1; } }
    }
};
struct EpiQK {
    static constexpr bool PERM = true, AFTER_DRAIN = false;
    bf16* q; bf16* k; const float* qg; const float* kg; float* nck;
    __device__ __forceinline__ void operator()(ACC_T, const pg8::Unit& u, int wr, int wc, int fr, int fq) const {
        const bool isq = u.pn < 4; const int head = 4 * (u.pn & 3) + wc;
        bf16* dst = isq ? q : k; const float* gn = isq ? qg : kg; const float osc = isq ? 0.125f * LOG2E : 1.0f;
        f32x4 g[2][2];
#pragma unroll
        for (int bj = 0; bj < 2; ++bj) { g[bj][0] = *(const f32x4*)(gn + 32 * bj + 8 * fq); g[bj][1] = *(const f32x4*)(gn + 32 * bj + 8 * fq + 4); }
        const int row0 = u.pm * 256 + wr * 64 + fr, col0 = head * 64 + 8 * fq;
#pragma unroll
        for (int ai = 0; ai < 2; ++ai)
#pragma unroll
            for (int m = 0; m < 4; ++m) { const int row = row0 + ai * 128 + m * 16;
                float ss = 0.f;
#pragma unroll
                for (int bj = 0; bj < 2; ++bj)
#pragma unroll
                    for (int n = 0; n < 2; ++n) { const af4 v = acc[ai][bj][m][n]; ss += (v[0] * v[0] + v[1] * v[1]) + (v[2] * v[2] + v[3] * v[3]); }
                ss += __shfl_xor(ss, 16); ss += __shfl_xor(ss, 32);
                const float rstd = __builtin_amdgcn_rsqf(ss * (1.0f / 64.0f) + EPS);
#pragma unroll
                for (int bj = 0; bj < 2; ++bj) { f32x4 v0 = acc[ai][bj][m][0] * rstd * g[bj][0], v1 = acc[ai][bj][m][1] * rstd * g[bj][1];
                    v0 *= osc; v1 *= osc;
                    u32x4 w; w.x = cvt_pk_bf16(v0[0], v0[1]); w.y = cvt_pk_bf16(v0[2], v0[3]); w.z = cvt_pk_bf16(v1[0], v1[1]); w.w = cvt_pk_bf16(v1[2], v1[3]);
                    *(u32x4*)(dst + (size_t)row * D + col0 + 32 * bj) = w; } }
    }
};
struct EpiVTattn {
    static constexpr bool PERM = true, AFTER_DRAIN = false;
    bf16* O; float* ncv;
    __device__ __forceinline__ void operator()(ACC_T, const pg8::Unit& u, int wr, int wc, int fr, int fq) const {
        const int row0 = u.pm * 256 + wr * 64 + fr, col0 = u.pn * 256 + wc * 32 + 8 * fq;
#pragma unroll
        for (int ai = 0; ai < 2; ++ai)
#pragma unroll
            for (int m = 0; m < 4; ++m) { const int row = row0 + ai * 128 + m * 16; bf16* rowp = O + (size_t)row * T + col0;
#pragma unroll
                for (int bj = 0; bj < 2; ++bj) { const af4 v0 = acc[ai][bj][m][0], v1 = acc[ai][bj][m][1];
                    u32x4 w; w.x = cvt_pk_bf16(v0[0], v0[1]); w.y = cvt_pk_bf16(v0[2], v0[3]); w.z = cvt_pk_bf16(v1[0], v1[1]); w.w = cvt_pk_bf16(v1[2], v1[3]);
                    *(u32x4*)(rowp + bj * 128) = w; } }
    }
};
struct EpiConvIn {
    static constexpr bool PERM = true, AFTER_DRAIN = false;
    bf16* bg; bf16* z;
    __device__ __forceinline__ void operator()(ACC_T, const pg8::Unit& u, int wr, int wc, int fr, int fq) const {
        const int row0 = u.pm * 256 + wr * 64 + fr;
#pragma unroll
        for (int ai = 0; ai < 2; ++ai)
#pragma unroll
            for (int m = 0; m < 4; ++m) { const size_t row = (size_t)(row0 + ai * 128 + m * 16);
                if (u.pn < 4) {
#pragma unroll
                    for (int bj = 0; bj < 2; ++bj) { const af4 v0 = acc[ai][bj][m][0], v1 = acc[ai][bj][m][1];
                        u32x4 w; w.x = cvt_pk_bf16(v0[0], v0[1]); w.y = cvt_pk_bf16(v0[2], v0[3]); w.z = cvt_pk_bf16(v1[0], v1[1]); w.w = cvt_pk_bf16(v1[2], v1[3]);
                        *(u32x4*)(bg + row * D + u.pn * 256 + bj * 128 + wc * 32 + 8 * fq) = w; }
                } else {
                    const af4 v0 = acc[ai][0][m][0] * acc[ai][1][m][0], v1 = acc[ai][0][m][1] * acc[ai][1][m][1];
                    u32x4 w; w.x = cvt_pk_bf16(v0[0], v0[1]); w.y = cvt_pk_bf16(v0[2], v0[3]); w.z = cvt_pk_bf16(v1[0], v1[1]); w.w = cvt_pk_bf16(v1[2], v1[3]);
                    *(u32x4*)(z + row * D + (u.pn - 4) * 128 + wc * 32 + 8 * fq) = w; } }
    }
};
struct Args { const float* in[25]; float* out; unsigned char* ws; int ph_lo, ph_hi; };
enum { I_XP = 0, I_XS, I_CK, I_CV, I_C, I_CCTX, I_NORMG, I_ADAW, I_ADAB, I_AWIN, I_AVG, I_AWS, I_ABS, I_AWOUT, I_BWQKV, I_BQG, I_BKG, I_RPB, I_BWO, I_CWIN, I_CCW, I_CCB, I_CWOUT, I_FW1, I_FW2 };

#define LDS_WAIT() asm volatile("s_waitcnt lgkmcnt(0)" ::: "memory")
__device__ __forceinline__ float wave_sum(float v) {
#pragma unroll
    for (int o = 1; o < 64; o <<= 1) v += __shfl_xor(v, o);
    return v;
}
__device__ __forceinline__ int rowmap(int mode, int n) {
    if (mode == 1) { if (n >= 2048) return n; const int sect = n >> 10, hh = (n & 1023) >> 6, d = n & 63; return 256 * (sect * 4 + (hh >> 2)) + 128 * (d >> 5) + 32 * (hh & 3) + (d & 31); }
    if (mode == 2) { if (n < 1024) return n; const int s = (n >= 2048), ch = n - 1024 - 1024 * s; return 1024 + 256 * (ch >> 7) + 128 * s + (ch & 127); }
    return n;
}
__device__ __forceinline__ void transpose_item(const float* W, int K, int N, bf16* WT, int mode, LAS float* scr, int item, int lane) {
    const int nblk = N / 32, kb = item / nblk, nb = item % nblk, k0 = 64 * kb, n0 = 32 * nb;
#pragma unroll 8
    for (int i = 0; i < 32; ++i) { const int kk = 2 * i + (lane >> 5); scr[kk * 33 + (lane & 31)] = W[(size_t)(k0 + kk) * N + n0 + (lane & 31)]; }
    LDS_WAIT(); asm volatile("" ::: "memory");
    const int c = lane & 7; const int r0 = rowmap(mode, n0);
#pragma unroll
    for (int j = 0; j < 4; ++j) { const int n = (lane >> 3) + 8 * j; const LAS float* s = scr + (8 * c) * 33 + n;
        u32x4 o; o.x = cvt_pk_bf16(s[0 * 33], s[1 * 33]); o.y = cvt_pk_bf16(s[2 * 33], s[3 * 33]); o.z = cvt_pk_bf16(s[4 * 33], s[5 * 33]); o.w = cvt_pk_bf16(s[6 * 33], s[7 * 33]);
        *(u32x4*)(WT + (size_t)(r0 + n) * K + k0 + 8 * c) = o; }
    LDS_WAIT(); asm volatile("" ::: "memory");
}
__device__ __forceinline__ void p0_prologue(const Args& a, LAS unsigned char* lds, int tid, int lane, int wave, int G) {
    unsigned char* ws = a.ws;
    if ((int)blockIdx.x < 192) {
        LAS float* sc = (LAS float*)lds;
        LAS float* red = (LAS float*)(lds + 40960);
        for (int e = tid; e < NCOND * D; e += 512) { const int c = e >> 10, k = e & 1023; const float v = (c < 8) ? a.in[I_C][c * D + k] : a.in[I_CCTX][k]; sc[e] = v * __builtin_amdgcn_rcpf(1.0f + __builtin_amdgcn_exp2f(-LOG2E * v)); }
        __syncthreads();
        const int item = blockIdx.x, l = item / 48, n0 = (item % 48) * 128;
        const float* W = a.in[I_ADAW] + (size_t)l * D * MODW + n0 + 2 * lane;
        float acc0[NCOND], acc1[NCOND];
#pragma unroll
        for (int c = 0; c < NCOND; ++c) { acc0[c] = 0.f; acc1[c] = 0.f; }
        const int kbeg = wave * 128;
#pragma unroll 2
        for (int k = kbeg; k < kbeg + 128; k += 4) {
            const f32x2 w0 = *(const f32x2*)(W + (size_t)k * MODW), w1 = *(const f32x2*)(W + (size_t)(k + 1) * MODW), w2 = *(const f32x2*)(W + (size_t)(k + 2) * MODW), w3 = *(const f32x2*)(W + (size_t)(k + 3) * MODW);
#pragma unroll
            for (int c = 0; c < NCOND; ++c) { const f32x4 s = *(const LAS f32x4*)(sc + c * D + k);
                acc0[c] += s[0] * w0[0] + s[1] * w1[0] + s[2] * w2[0] + s[3] * w3[0]; acc1[c] += s[0] * w0[1] + s[1] * w1[1] + s[2] * w2[1] + s[3] * w3[1]; }
        }
#pragma unroll
        for (int c = 0; c < NCOND; ++c) { *(LAS f32x2*)(red + (wave * NCOND + c) * 128 + 2 * lane) = (f32x2){acc0[c], acc1[c]}; }
        __syncthreads();
        float* mod = (float*)(ws + WS_MOD);
        for (int e = tid; e < NCOND * 128; e += 512) { const int c = e >> 7, n = e & 127; float s = a.in[I_ADAB][l * MODW + n0 + n];
#pragma unroll
            for (int w = 0; w < 8; ++w) s += red[(w * NCOND + c) * 128 + n];
            mod[(size_t)(l * NCOND + c) * MODW + n0 + n] = s; }
        __syncthreads();
    }
    LAS float* scr = (LAS float*)(lds + wave * 16384);
    const int gw = blockIdx.x * 8 + wave, NGW = G * 8;
    constexpr int NIT = 28672;
    for (int it = gw; it < NIT; it += NGW) {
        int r = it;
#define TR(cnt, W, K, N, WT, mode) if (r < (cnt)) { transpose_item((W), (K), (N), (WT), (mode), scr, r, lane); continue; } r -= (cnt);
        TR(2048, a.in[I_AWIN], D, 4096, (bf16*)(ws + WS_WA_IN), 0)
        TR(2048, a.in[I_AWIN] + (size_t)D * 4096, D, 4096, (bf16*)(ws + WS_WA_IN + 8 * MiB), 0)
        TR(1024, a.in[I_AWOUT], AH, D, (bf16*)(ws + WS_WA_OUT), 0)
        TR(1024, a.in[I_AWOUT] + (size_t)AH * D, AH, D, (bf16*)(ws + WS_WA_OUT + 4 * MiB), 0)
        TR(1536, a.in[I_BWQKV], D, 3072, (bf16*)(ws + WS_WB_QKV), 1)
        TR(512, a.in[I_BWO], D, D, (bf16*)(ws + WS_WB_O), 0)
        TR(1536, a.in[I_CWIN], D, 3072, (bf16*)(ws + WS_WC_IN), 2)
        TR(512, a.in[I_CWOUT], D, D, (bf16*)(ws + WS_WC_OUT), 0)
        { const int l = r >> 11; if (l < 4) { transpose_item(a.in[I_FW1] + (size_t)l * D * FF, D, FF, (bf16*)(ws + WS_WF1 + (size_t)l * 8 * MiB), 0, scr, r & 2047, lane); continue; } r -= 8192; }
        { const int l = r >> 11; if (l < 4) { transpose_item(a.in[I_FW2] + (size_t)l * D * FF, FF, D, (bf16*)(ws + WS_WF2 + (size_t)l * 8 * MiB), 0, scr, r & 2047, lane); continue; } r -= 8192; }
        { const int b = r >> 8; transpose_item(a.in[I_CV] + (size_t)b * 512 * D, 512, D, (bf16*)(ws + WS_CVT) + (size_t)b * D * 512, 0, scr, r & 255, lane); }
#undef TR
    }
    { const f32x4* src = (const f32x4*)a.in[I_CK]; u32x4* dst = (u32x4*)(ws + WS_CKB);
      for (int e = blockIdx.x * 512 + tid; e < 8 * 512 * D / 8; e += G * 512) { const f32x4 v0 = src[2 * e], v1 = src[2 * e + 1];
          u32x4 w; w.x = cvt_pk_bf16(v0[0], v0[1]); w.y = cvt_pk_bf16(v0[2], v0[3]); w.z = cvt_pk_bf16(v1[0], v1[1]); w.w = cvt_pk_bf16(v1[2], v1[3]); dst[e] = w; } }
}
__device__ __forceinline__ void norm_phase(const Args& a, int l, int which, bool first, int lane, int wave, int G) {
    const float* g = a.in[I_NORMG] + (size_t)(l * 2 + which) * D;
    const float* mod = (const float*)(a.ws + WS_MOD) + (size_t)l * NCOND * MODW + which * 3 * D;
    bf16* H = (bf16*)(a.ws + WS_H);
    f32x4 gv[4];
#pragma unroll
    for (int j = 0; j < 4; ++j) gv[j] = *((const f32x4*)g + lane + 64 * j);
    for (int m = blockIdx.x * 8 + wave; m < T; m += G * 8) {
        const float* xr = first ? (m < TP ? a.in[I_XP] + (size_t)m * D : a.in[I_XS] + (size_t)(m - TP) * D) : a.out + (size_t)m * D;
        const float* mp = mod + (size_t)cond_of_row(m) * MODW;
        f32x4 v[4]; float s = 0.f;
#pragma unroll
        for (int j = 0; j < 4; ++j) { v[j] = *((const f32x4*)xr + lane + 64 * j); s += (v[j][0] * v[j][0] + v[j][1] * v[j][1]) + (v[j][2] * v[j][2] + v[j][3] * v[j][3]); }
        if (first) {
#pragma unroll
            for (int j = 0; j < 4; ++j) *((f32x4*)(a.out + (size_t)m * D) + lane + 64 * j) = v[j]; }
        const float rstd = __builtin_amdgcn_rsqf(wave_sum(s) * (1.0f / D) + EPS);
        u32x2* o8 = (u32x2*)(H + (size_t)m * D) + lane;
#pragma unroll
        for (int j = 0; j < 4; ++j) { const f32x4 sh = *((const f32x4*)mp + lane + 64 * j), scl = *((const f32x4*)(mp + D) + lane + 64 * j);
            const f32x4 y = (v[j] * rstd * gv[j]) * (scl + 1.0f) + sh;
            u32x2 w; w.x = cvt_pk_bf16(y[0], y[1]); w.y = cvt_pk_bf16(y[2], y[3]); o8[64 * j] = w; }
    }
}
#define MFMA32(a, b, c) __builtin_amdgcn_mfma_f32_32x32x16_bf16((a), (b), (c), 0, 0, 0)
__device__ __forceinline__ void gating_phase(const Args& a, int j, LAS unsigned char* lds, int tid, int lane, int wave, int G) {
    const bf16* U = (const bf16*)(a.ws + WS_BUF1); const bf16* VT = U + (size_t)T * AH; bf16* Aout = (bf16*)(a.ws + WS_BUF2);
    const float* part = (const float*)(a.ws + WS_PART);
    const float* wsm = a.in[I_AWS] + (size_t)j * 8 * 128 * 128; const float* bsm = a.in[I_ABS] + (size_t)j * 8 * 128; const float* gain = a.in[I_AVG] + (size_t)j * AH;
    LAS unsigned char* Al = lds;
    LAS float* rq = (LAS float*)(lds + 36864);
    LAS float* bsl = (LAS float*)(lds + 36864 + 512);
    const int l31 = lane & 31, hf = lane >> 5;
    for (int unit = blockIdx.x; unit < 768; unit += G) {
        const int chunk = unit >> 3, g = unit & 7, t0 = chunk * 128;
        if (tid < 128) { const f32x4* pp = (const f32x4*)(part + (size_t)(t0 + tid) * 16); const f32x4 p0 = pp[0], p1 = pp[1], p2 = pp[2], p3 = pp[3];
            const float s = ((p0[0] + p0[1]) + (p0[2] + p0[3])) + ((p1[0] + p1[1]) + (p1[2] + p1[3])) + ((p2[0] + p2[1]) + (p2[2] + p2[3])) + ((p3[0] + p3[1]) + (p3[2] + p3[3]));
            rq[tid] = __builtin_amdgcn_rsqf(s * (1.0f / AH) + EPS); bsl[tid] = bsm[g * 128 + tid]; }
        __syncthreads();
        { const int p = tid >> 2, q0 = (tid & 3) * 32; const float* src = wsm + ((size_t)g * 128 + p) * 128 + q0;
#pragma unroll
          for (int c = 0; c < 4; ++c) { const f32x4 w0 = *(const f32x4*)(src + 8 * c), w1 = *(const f32x4*)(src + 8 * c + 4); const f32x4 r0 = *(const LAS f32x4*)(rq + q0 + 8 * c), r1 = *(const LAS f32x4*)(rq + q0 + 8 * c + 4);
              u32x4 w; w.x = cvt_pk_bf16(w0[0] * r0[0], w0[1] * r0[1]); w.y = cvt_pk_bf16(w0[2] * r0[2], w0[3] * r0[3]); w.z = cvt_pk_bf16(w1[0] * r1[0], w1[1] * r1[1]); w.w = cvt_pk_bf16(w1[2] * r1[2], w1[3] * r1[3]);
              *(LAS u32x4*)(Al + p * 272 + (q0 + 8 * c) * 2) = w; } }
        __syncthreads();
        const int ch = g * 256 + wave * 32 + l31;
        const bf16* vp = VT + (size_t)ch * T + t0 + 8 * hf;
        bf16x8 bfr[8];
#pragma unroll
        for (int ks = 0; ks < 8; ++ks) bfr[ks] = *(const bf16x8*)(vp + 16 * ks);
        f32x16 acc[4];
#pragma unroll
        for (int mt = 0; mt < 4; ++mt) {
#pragma unroll
            for (int i = 0; i < 16; ++i) acc[mt][i] = 0.f;
#pragma unroll
            for (int ks = 0; ks < 8; ++ks) { const bf16x8 af = *(const LAS bf16x8*)(Al + (32 * mt + l31) * 272 + (16 * ks + 8 * hf) * 2); acc[mt] = MFMA32(af, bfr[ks], acc[mt]); }
        }
        const float gn = gain[ch];
#pragma unroll
        for (int mt = 0; mt < 4; ++mt)
#pragma unroll
            for (int i = 0; i < 16; ++i) { const int p = 32 * mt + 8 * (i >> 2) + 4 * hf + (i & 3); const size_t off = (size_t)(t0 + p) * AH + ch;
                const float s = acc[mt][i] * gn + bsl[p]; const float uu = bf2f(U[off]);
                Aout[off] = (bf16)(cvt_pk_bf16(uu * s, 0.f) & 0xffffu); }
        __syncthreads();
    }
}
__device__ __forceinline__ void conv_phase(const Args& a, int j, int lane, int wave, int G) {
    const bf16* BG = (const bf16*)(a.ws + WS_BUF1); const bf16* Z = BG + (size_t)T * D; bf16* A2 = (bf16*)(a.ws + WS_BUF2);
    const float* cw = a.in[I_CCW] + (size_t)j * 3 * D; const float* cb = a.in[I_CCB] + (size_t)j * D;
    for (int m = blockIdx.x * 8 + wave; m < T; m += G * 8) {
        const int tpos = m < TP ? (m & 255) : ((m - TP) & 1023), L = m < TP ? 256 : 1024;
        const bool hasp = tpos > 0, hasn = tpos < L - 1;
#pragma unroll
        for (int hh = 0; hh < 2; ++hh) { const int ch = 8 * lane + 512 * hh;
            const bf16x8 zc = *(const bf16x8*)(Z + (size_t)m * D + ch), bgv = *(const bf16x8*)(BG + (size_t)m * D + ch);
            bf16x8 zp = zc, zn = zc; if (hasp) zp = *(const bf16x8*)(Z + (size_t)(m - 1) * D + ch); if (hasn) zn = *(const bf16x8*)(Z + (size_t)(m + 1) * D + ch);
            float r[8];
#pragma unroll
            for (int e = 0; e < 8; ++e) { float v = cb[ch + e] + bf2f((unsigned short)zc[e]) * cw[D + ch + e];
                if (hasp) v += bf2f((unsigned short)zp[e]) * cw[ch + e]; if (hasn) v += bf2f((unsigned short)zn[e]) * cw[2 * D + ch + e];
                r[e] = v * bf2f((unsigned short)bgv[e]); }
            u32x4 w; w.x = cvt_pk_bf16(r[0], r[1]); w.y = cvt_pk_bf16(r[2], r[3]); w.z = cvt_pk_bf16(r[4], r[5]); w.w = cvt_pk_bf16(r[6], r[7]);
            *(u32x4*)(A2 + (size_t)m * D + ch) = w; }
    }
}
constexpr int AT_KP = 144, AT_VP = 136, AT_KB = 64 * AT_KP, AT_STAGE = 64 * AT_KP + 64 * AT_VP, AT_BUF0 = 2048;
template <bool LOCAL>
__device__ __forceinline__ void attn_stage(const bf16x8 (&qf)[4], const LAS unsigned char* kl, const LAS unsigned char* vl, f32x16& o0, f32x16& o1, float& mrun, float& lsum,
                                           const LAS float* rp, int cq, int cs, int l31, int hf) {
    f32x16 s0, s1;
#pragma unroll
    for (int i = 0; i < 16; ++i) { s0[i] = 0.f; s1[i] = 0.f; }
    const LAS unsigned char* kp = kl + l31 * AT_KP + hf * 16;
#pragma unroll
    for (int ks = 0; ks < 4; ++ks) { const bf16x8 ka = *(const LAS bf16x8*)(kp + ks * 32), kb = *(const LAS bf16x8*)(kp + 32 * AT_KP + ks * 32);
        s0 = MFMA32(ka, qf[ks], s0); s1 = MFMA32(kb, qf[ks], s1); }
    if (LOCAL) {
#pragma unroll
        for (int tl = 0; tl < 2; ++tl) {
            const int d0 = 32 * tl + 4 * hf - cq + 15, e0 = 32 * tl + 4 * hf - cs;
            float bias[16];
#pragma unroll
            for (int i = 0; i < 16; ++i) { int idx = d0 + 8 * (i >> 2) + (i & 3); idx = idx < 0 ? 0 : (idx > 30 ? 30 : idx); bias[i] = rp[idx]; }
            asm volatile("" : "+v"(bias[0]), "+v"(bias[1]), "+v"(bias[2]), "+v"(bias[3]), "+v"(bias[4]), "+v"(bias[5]), "+v"(bias[6]), "+v"(bias[7]),
                              "+v"(bias[8]), "+v"(bias[9]), "+v"(bias[10]), "+v"(bias[11]), "+v"(bias[12]), "+v"(bias[13]), "+v"(bias[14]), "+v"(bias[15]));
#pragma unroll
            for (int i = 0; i < 16; ++i) { const bool ok = (unsigned)(e0 + 8 * (i >> 2) + (i & 3)) < 16u;
                if (tl == 0) s0[i] = ok ? s0[i] + bias[i] : -INFINITY; else s1[i] = ok ? s1[i] + bias[i] : -INFINITY; }
        }
    }
    float mx = fmaxf(s0[0], s1[0]);
#pragma unroll
    for (int i = 1; i < 16; ++i) mx = fmaxf(mx, fmaxf(s0[i], s1[i]));
    mx = fmaxf(mx, __shfl_xor(mx, 32));
    const float mn = fmaxf(mrun, mx), sc = __builtin_amdgcn_exp2f(mrun - mn); mrun = mn;
    float ps = 0.f;
#pragma unroll
    for (int i = 0; i < 16; ++i) { s0[i] = __builtin_amdgcn_exp2f(s0[i] - mn); s1[i] = __builtin_amdgcn_exp2f(s1[i] - mn); ps += s0[i] + s1[i]; }
    lsum = lsum * sc + ps; o0 *= sc; o1 *= sc;
    bf16x8 pb[4];
    { u32x4 w; w.x = cvt_pk_bf16(s0[0], s0[1]); w.y = cvt_pk_bf16(s0[2], s0[3]); w.z = cvt_pk_bf16(s0[4], s0[5]); w.w = cvt_pk_bf16(s0[6], s0[7]); pb[0] = __builtin_bit_cast(bf16x8, w);
      w.x = cvt_pk_bf16(s0[8], s0[9]); w.y = cvt_pk_bf16(s0[10], s0[11]); w.z = cvt_pk_bf16(s0[12], s0[13]); w.w = cvt_pk_bf16(s0[14], s0[15]); pb[1] = __builtin_bit_cast(bf16x8, w);
      w.x = cvt_pk_bf16(s1[0], s1[1]); w.y = cvt_pk_bf16(s1[2], s1[3]); w.z = cvt_pk_bf16(s1[4], s1[5]); w.w = cvt_pk_bf16(s1[6], s1[7]); pb[2] = __builtin_bit_cast(bf16x8, w);
      w.x = cvt_pk_bf16(s1[8], s1[9]); w.y = cvt_pk_bf16(s1[10], s1[11]); w.z = cvt_pk_bf16(s1[12], s1[13]); w.w = cvt_pk_bf16(s1[14], s1[15]); pb[3] = __builtin_bit_cast(bf16x8, w); }
    const LAS unsigned char* vp = vl + l31 * AT_VP + hf * 8;
#pragma unroll
    for (int c = 0; c < 4; ++c) {
        const s16x4 a0 = *(const LAS s16x4*)(vp + c * 32), a1 = *(const LAS s16x4*)(vp + c * 32 + 16);
        const s16x4 b0 = *(const LAS s16x4*)(vp + 32 * AT_VP + c * 32), b1 = *(const LAS s16x4*)(vp + 32 * AT_VP + c * 32 + 16);
        o0 = MFMA32(__builtin_shufflevector(a0, a1, 0, 1, 2, 3, 4, 5, 6, 7), pb[c], o0);
        o1 = MFMA32(__builtin_shufflevector(b0, b1, 0, 1, 2, 3, 4, 5, 6, 7), pb[c], o1); }
}
__device__ __forceinline__ void attn_phase(const Args& a, LAS unsigned char* lds, int tid, int lane, int wave, int G) {
    const bf16* Q = (const bf16*)(a.ws + WS_BUF1); const bf16* Kb = Q + (size_t)T * D; const bf16* VT = Kb + (size_t)T * D;
    const bf16* CKB = (const bf16*)(a.ws + WS_CKB); const bf16* CVT = (const bf16*)(a.ws + WS_CVT);
    bf16* O = (bf16*)(a.ws + WS_BUF2);
    LAS float* rpl = (LAS float*)lds;
    const int l31 = lane & 31, hf = lane >> 5;
    { float* nck = a.out + (size_t)T * D; float* ncv = nck + (size_t)TP * D;
      for (int e = blockIdx.x * 512 + tid; e < TP * D / 8; e += G * 512) { const bf16x8 v = *((const bf16x8*)Kb + e); f32x4 lo, hi;
#pragma unroll
          for (int i = 0; i < 4; ++i) { lo[i] = bf2f((unsigned short)v[i]); hi[i] = bf2f((unsigned short)v[4 + i]); }
          *((f32x4*)nck + 2 * e) = lo; *((f32x4*)nck + 2 * e + 1) = hi; }
      LAS float* scr = (LAS float*)(lds + 2048 + wave * 8704);
      for (int item = blockIdx.x * 8 + wave; item < 2048; item += G * 8) { const int ch0 = (item >> 6) * 32, tok0 = (item & 63) * 64;
#pragma unroll 4
          for (int i = 0; i < 16; ++i) { const int cr = 2 * i + hf; const unsigned w = *(const unsigned*)(VT + (size_t)(ch0 + cr) * T + tok0 + 2 * l31);
              scr[(2 * l31) * 33 + cr] = __uint_as_float(w << 16); scr[(2 * l31 + 1) * 33 + cr] = __uint_as_float(w & 0xffff0000u); }
          LDS_WAIT(); asm volatile("" ::: "memory");
#pragma unroll 4
          for (int i = 0; i < 32; ++i) { const int tr = 2 * i + hf; ncv[(size_t)(tok0 + tr) * D + ch0 + l31] = scr[tr * 33 + l31]; }
          LDS_WAIT(); asm volatile("" ::: "memory"); } }
    const int srow = tid >> 3, schunk = tid & 7;
    for (int unit = blockIdx.x; unit < 768; unit += G) {
        int qrow, h, ns, b, r = 0, rlo = 0, tb = 0, cq = 0, cs = 0, start = 0;
        const bool nat = unit < 512;
        f32x16 o0, o1;
#pragma unroll
        for (int i = 0; i < 16; ++i) { o0[i] = 0.f; o1[i] = 0.f; }
        float mrun = -1e30f, lsum = 0.f;
        __syncthreads();
        if (nat) {
            b = unit >> 6; h = (unit >> 2) & 15; r = 4 * (unit & 3) + (wave >> 1); const int half = wave & 1;
            if (tid < 465) rpl[tid] = a.in[I_RPB][h * 465 + tid] * LOG2E;
            tb = TP + b * 1024; qrow = tb + r * 64 + 32 * half + l31;
            start = r - 4; start = start < 0 ? 0 : (start > 8 ? 8 : start);
            cq = 32 * half + l31; cs = cq - 8; cs = cs < 0 ? 0 : (cs > 48 ? 48 : cs);
            rlo = 4 * (unit & 3) - 4; rlo = rlo < 0 ? 0 : (rlo > 8 ? 8 : rlo); int rhi = 4 * (unit & 3) + 3 - 4; rhi = (rhi < 0 ? 0 : (rhi > 8 ? 8 : rhi)) + 7;
            ns = 8 + (rhi - rlo + 1);
        } else { b = (unit - 512) >> 4; h = (unit - 512) & 15; qrow = b * 256 + 32 * wave + l31; ns = 4; }
        bf16x8 qf[4];
        { const bf16* qp = Q + (size_t)qrow * D + h * 64 + 8 * hf;
#pragma unroll
          for (int ks = 0; ks < 4; ++ks) qf[ks] = *(const bf16x8*)(qp + 16 * ks); }
        u32x4 kr, vr;
#define AT_ISSUE(st) do { const bf16* ks_; const bf16* vs_; \
            if (!nat) { ks_ = Kb + (size_t)(b * 256 + 64 * (st) + srow) * D + h * 64 + 8 * schunk; vs_ = VT + (size_t)(h * 64 + srow) * T + b * 256 + 64 * (st) + 8 * schunk; } \
            else if ((st) < 8) { ks_ = CKB + (size_t)(b * 512 + 64 * (st) + srow) * D + h * 64 + 8 * schunk; vs_ = CVT + (size_t)(b * D + h * 64 + srow) * 512 + 64 * (st) + 8 * schunk; } \
            else { const int t0_ = tb + (rlo + (st) - 8) * 64; ks_ = Kb + (size_t)(t0_ + srow) * D + h * 64 + 8 * schunk; vs_ = VT + (size_t)(h * 64 + srow) * T + t0_ + 8 * schunk; } \
            kr = *(const u32x4*)ks_; vr = *(const u32x4*)vs_; } while (0)
        AT_ISSUE(0);
        for (int st = 0; st < ns; ++st) {
            LAS unsigned char* buf = lds + AT_BUF0 + (st & 1) * AT_STAGE;
            *(LAS u32x4*)(buf + srow * AT_KP + schunk * 16) = kr;
            *(LAS u32x2*)(buf + AT_KB + srow * AT_VP + schunk * 16) = (u32x2){vr.x, vr.y}; *(LAS u32x2*)(buf + AT_KB + srow * AT_VP + schunk * 16 + 8) = (u32x2){vr.z, vr.w};
            if (st + 1 < ns) AT_ISSUE(st + 1);
            __syncthreads();
            if (!nat || st < 8) attn_stage<false>(qf, buf, buf + AT_KB, o0, o1, mrun, lsum, rpl, 0, 0, l31, hf);
            else { const int rr = rlo + st - 8; if (rr >= start && rr < start + 8) attn_stage<true>(qf, buf, buf + AT_KB, o0, o1, mrun, lsum, rpl + (rr - r + 7) * 31, cq, cs, l31, hf); }
        }
#undef AT_ISSUE
        const float inv = 1.0f / (lsum + __shfl_xor(lsum, 32));
        bf16* op = O + (size_t)qrow * D + h * 64 + 4 * hf;
#pragma unroll
        for (int b4 = 0; b4 < 4; ++b4) {
            u32x2 w; w.x = cvt_pk_bf16(o0[4 * b4] * inv, o0[4 * b4 + 1] * inv); w.y = cvt_pk_bf16(o0[4 * b4 + 2] * inv, o0[4 * b4 + 3] * inv); *(u32x2*)(op + 8 * b4) = w;
            w.x = cvt_pk_bf16(o1[4 * b4] * inv, o1[4 * b4 + 1] * inv); w.y = cvt_pk_bf16(o1[4 * b4 + 2] * inv, o1[4 * b4 + 3] * inv); *(u32x2*)(op + 32 + 8 * b4) = w; }
    }
}
#define XB_TMO      128
#define XB_XCNT(j)  (256  + 64 * (j))
#define XB_XSUB(j)  (1280 + 64 * (j))
#define XB_XGEN(j)  (2304 + 64 * (j))
#define XB_TOP      3328
#define XB_TOPGEN   3392
#define XCD_BAR_WORDS 3456
#define XB_SPIN_CAP (1u << 18)

__device__ __forceinline__ unsigned xb_ld(unsigned* p)              { return __hip_atomic_load(p, __ATOMIC_RELAXED, __HIP_MEMORY_SCOPE_AGENT); }
__device__ __forceinline__ unsigned xb_add(unsigned* p, unsigned v) { return __hip_atomic_fetch_add(p, v, __ATOMIC_RELAXED, __HIP_MEMORY_SCOPE_AGENT); }
__device__ __forceinline__ unsigned xb_xcc_id() { return (unsigned)__builtin_amdgcn_s_getreg((3 << 11) | 20) & 0xFu; }
#define XB_SPIN(cond, bar) do { unsigned _sp = 0; while (cond) { __builtin_amdgcn_s_sleep(1); \
    if ((++_sp & 255u) == 0u) { if (xb_ld(&(bar)[XB_TMO])) break; if (_sp > XB_SPIN_CAP) { atomicAdd(&(bar)[XB_TMO], 1u); break; } } } } while (0)

struct XcdBarrier {
    unsigned* bar; unsigned x;
    volatile LAS unsigned* st;
};

__device__ __forceinline__ XcdBarrier xcd_barrier_post(unsigned* bar, volatile LAS unsigned* st) {
    XcdBarrier b; b.bar = bar; b.x = xb_xcc_id(); b.st = st;
    if (threadIdx.x == 0) (void)xb_add(&bar[XB_XCNT(b.x)], 1u);
    return b;
}
__device__ __forceinline__ void xcd_barrier_complete(unsigned* bar, unsigned x, unsigned& nloc, unsigned& nx) {
    const unsigned G = gridDim.x * gridDim.y * gridDim.z;
    unsigned sum, cnt, mine, sp = 0u;
    for (;;) {
        sum = 0u; cnt = 0u; mine = 0u;
#pragma unroll
        for (unsigned j = 0; j < 16; ++j) { const unsigned c = xb_ld(&bar[XB_XCNT(j)]); sum += c; cnt += (c > 0u) ? 1u : 0u; mine = (j == x) ? c : mine; }
        if (sum == G) break;
        __builtin_amdgcn_s_sleep(1);
        if ((++sp & 255u) == 0u) { if (xb_ld(&bar[XB_TMO])) break; if (sp > XB_SPIN_CAP) { atomicAdd(&bar[XB_TMO], 1u); break; } }
    }
    nloc = mine > 0u ? mine : 1u; nx = cnt > 0u ? cnt : 1u;
}

__device__ __forceinline__ void xcd_barrier(const XcdBarrier& b) {
    asm volatile("s_waitcnt vmcnt(0)" ::: "memory");
    __syncthreads();
    if (threadIdx.x == 0) {
        unsigned* bar = b.bar;
        __builtin_amdgcn_s_waitcnt(0);
        unsigned nloc = b.st[0], nx = b.st[1];
        if (nloc == 0u) { xcd_barrier_complete(bar, b.x, nloc, nx); b.st[0] = nloc; b.st[1] = nx; }
        const unsigned old = xb_add(&bar[XB_XSUB(b.x)], 1u);
        const unsigned gen = old / nloc;
        if (old + 1u == (gen + 1u) * nloc) {
            __builtin_amdgcn_fence(__ATOMIC_RELEASE, "agent");
            asm volatile("s_waitcnt vmcnt(0)" ::: "memory");
            const unsigned og = xb_add(&bar[XB_TOP], 1u);
            const unsigned tg = og / nx;
            if (og + 1u == (tg + 1u) * nx) xb_add(&bar[XB_TOPGEN], 1u);
            else XB_SPIN(xb_ld(&bar[XB_TOPGEN]) == tg, bar);
            __builtin_amdgcn_fence(__ATOMIC_ACQUIRE, "agent");
            xb_add(&bar[XB_XGEN(b.x)], 1u);
            asm volatile("s_waitcnt vmcnt(0)" ::: "memory");
        } else {
            XB_SPIN(xb_ld(&bar[XB_XGEN(b.x)]) == gen, bar);
            __builtin_amdgcn_fence(__ATOMIC_ACQUIRE, "agent");
            asm volatile("s_waitcnt vmcnt(0)" ::: "memory");
        }
    }
    __syncthreads();
}


struct EpiU {
    static constexpr bool PERM = true, AFTER_DRAIN = false;
    int type; int ldc; bf16* b0; bf16* b1; const float* f0; const float* f1; float* o0;
    __device__ __forceinline__ void operator()(ACC_T, const pg8::Unit& u, int wr_, int wc_, int fr_, int fq_) const {
        int wr = wr_, wc = wc_, fr = fr_, fq = fq_; asm volatile("" : "+s"(wr), "+s"(wc), "+v"(fr), "+v"(fq));
        switch (type) {
            case 0: { EpiAct<1> E{b0, ldc}; E(acc, u, wr, wc, fr, fq); } break;
            case 1: { EpiAct<2> E{b0, ldc}; E(acc, u, wr, wc, fr, fq); } break;
            case 2: { EpiVT E{b0, o0}; E(acc, u, wr, wc, fr, fq); } break;
            case 3: { EpiRes E{o0, f0}; E(acc, u, wr, wc, fr, fq); } break;
            case 4: { EpiQK E{b0, b1, f0, f1, o0}; E(acc, u, wr, wc, fr, fq); } break;
            case 5: { EpiVTattn E{b0, o0}; E(acc, u, wr, wc, fr, fq); } break;
            default: { EpiConvIn E{b0, b1}; E(acc, u, wr, wc, fr, fq); } break;
        }
    }
};
#ifndef DUP
#define DUP 0
#endif
#ifndef DUPK
#define DUPK 7
#endif
constexpr size_t WS_SCR = 296 * MiB;
#ifndef EN
#define EN 0xffff
#endif
__global__ void __launch_bounds__(512, 2) fwd_kernel(Args a) {
    extern __shared__ __attribute__((aligned(16))) unsigned char lds_raw[];
    LAS unsigned char* lds = (LAS unsigned char*)lds_raw;
    cg::grid_group grid = cg::this_grid();
    const int G = gridDim.x;
    unsigned char* ws = a.ws;
    if (threadIdx.x < 16) ((LAS unsigned*)(lds + 131072 + 64))[threadIdx.x] = 0u;
    if (blockIdx.x == 0) for (int i = threadIdx.x; i < XCD_BAR_WORDS; i += 512) ((unsigned*)(ws + WS_CTL))[i] = 0u;
    __syncthreads();
    XcdBarrier xb; xb.bar = (unsigned*)(ws + WS_CTL); xb.x = 0; xb.st = (volatile LAS unsigned*)(lds + 131072 + 64);
    for (int ph = a.ph_lo; ph < a.ph_hi; ++ph) {
        const int sdup = ph == 0 ? 0 : 1 + (ph - 1) % 7;
        int nrep = (((DUP >> sdup) & 1) && ((DUPK >> (ph == 0 ? 0 : ((ph - 1) / 7) % 3)) & 1)) ? 2 : 1; asm volatile("" : "+s"(nrep));
#pragma clang loop unroll(disable)
        for (int rep = 0; rep < nrep; ++rep) {
        int tid = threadIdx.x; asm volatile("" : "+v"(tid));
        const int lane = tid & 63, wave = __builtin_amdgcn_readfirstlane(tid >> 6);
        bf16* H = (bf16*)(ws + WS_H); bf16* B1 = (bf16*)(ws + WS_BUF1); bf16* B2 = (bf16*)(ws + WS_BUF2);
        if (ph == 0) { if (EN & 1) p0_prologue(a, lds, tid, lane, wave, G); }
        else {
            const int l = (ph - 1) / 7, s = (ph - 1) % 7, kind = l % 3, j = l / 3;
            const float* modl = (const float*)(ws + WS_MOD) + (size_t)l * NCOND * MODW;
            if (s == 0 || s == 4) { if (EN & 2) norm_phase(a, l, s == 4, ph == 1, lane, wave, G); }
            else if (s == 2) {
                if (kind == 0) { if (EN & 512) gating_phase(a, j, lds, tid, lane, wave, G); }
                else if (kind == 1) { if (EN & 1024) attn_phase(a, lds, tid, lane, wave, G); }
                else { if (EN & 2048) conv_phase(a, j, lane, wave, G); }
            } else if (EN & 4) {
                for (int gi = 0; gi < 2; ++gi) {
                    const bf16* A = H; const bf16* Bt; int M = T, N, K = D, shift = 0; EpiU E{};
                    if (s == 5) { if (gi) break; Bt = (const bf16*)(ws + WS_WF1 + (size_t)l * 8 * MiB); N = FF; E.type = 1; E.b0 = B1; E.ldc = FF; }
                    else if (s == 6) { if (gi) break; A = B1; Bt = (const bf16*)(ws + WS_WF2 + (size_t)l * 8 * MiB); N = D; K = FF; E.type = 3; E.o0 = (nrep == 2 && rep == 0) ? (float*)(ws + WS_SCR) : a.out; E.f0 = modl + 5 * D; }
                    else if (s == 3) { if (gi) break; A = B2; Bt = (const bf16*)(ws + (kind == 0 ? WS_WA_OUT + (size_t)j * 4 * MiB : (kind == 1 ? WS_WB_O : WS_WC_OUT))); N = D; K = kind == 0 ? AH : D; E.type = 3; E.o0 = (nrep == 2 && rep == 0) ? (float*)(ws + WS_SCR) : a.out; E.f0 = modl + 2 * D; }
                    else if (kind == 0) { const bf16* W = (const bf16*)(ws + WS_WA_IN + (size_t)j * 8 * MiB);
                        if (gi == 0) { Bt = W; N = AH; E.type = 0; E.b0 = B1; E.ldc = AH; }
                        else { A = W + (size_t)AH * D; Bt = H; M = AH; N = T; shift = 128; E.type = 2; E.b0 = B1 + (size_t)T * AH; E.o0 = (float*)(ws + WS_PART); } }
                    else if (kind == 1) { const bf16* W = (const bf16*)(ws + WS_WB_QKV);
                        if (gi == 0) { Bt = W; N = 2048; E.type = 4; E.b0 = B1; E.b1 = B1 + (size_t)T * D; E.f0 = a.in[I_BQG] + j * 64; E.f1 = a.in[I_BKG] + j * 64; E.o0 = a.out + (size_t)T * D; }
                        else { A = W + (size_t)2048 * D; Bt = H; M = D; N = T; shift = 128; E.type = 5; E.b0 = B1 + (size_t)2 * T * D; E.o0 = a.out + (size_t)T * D + (size_t)TP * D; } }
                    else { if (gi) break; Bt = (const bf16*)(ws + WS_WC_IN); N = 3072; E.type = 6; E.b0 = B1; E.b1 = B1 + (size_t)T * D; }
                    pg8::Gemm g{A, Bt, M, N, K}; pg8::StaticOrder S; S.init(M, N, G, (int)((blockIdx.x + shift) % G));
                    pg8::gemm_phase<EpiU, pg8::StaticOrder, true, true>(lds, g, S, E);
                }
            }
        }
        }
        if (ph + 1 < a.ph_hi) {
            if (ph == a.ph_lo) { grid.sync(); xb = xcd_barrier_post((unsigned*)(ws + WS_CTL), (volatile LAS unsigned*)(lds + 131072 + 64)); }
            else { xcd_barrier(xb); if (DUP & 256) xcd_barrier(xb); }
        }
    }
}

#ifndef N_LAUNCH_MODE
#define N_LAUNCH_MODE 1
#endif
extern "C" void kernel_launch(void* const* d_in, const int* in_sizes, int n_in, void* d_out, int out_size, void* d_ws, size_t ws_size, hipStream_t stream) {
    static int grid = 0;
    if (grid == 0) {
        if (n_in != 25 || ws_size < WS_END) { fprintf(stderr, "kernel_launch: unexpected n_in %d or ws_size %zu\n", n_in, ws_size); grid = -1; return; }
        int dev = 0, cus = 0, per_cu = 0;
        hipGetDevice(&dev); hipDeviceGetAttribute(&cus, hipDeviceAttributeMultiprocessorCount, dev);
        if (hipFuncSetAttribute((const void*)fwd_kernel, hipFuncAttributeMaxDynamicSharedMemorySize, LDS_BYTES) != hipSuccess) { fprintf(stderr, "kernel_launch: hipFuncSetAttribute failed\n"); grid = -1; return; }
        if (hipOccupancyMaxActiveBlocksPerMultiprocessor(&per_cu, (const void*)fwd_kernel, 512, LDS_BYTES) != hipSuccess || per_cu < 1) { fprintf(stderr, "kernel_launch: occupancy query says %d\n", per_cu); per_cu = 1; }
        (void)hipGetLastError();
        grid = cus * per_cu;
        fprintf(stderr, "kernel_launch: grid %d (cus %d x %d)\n", grid, cus, per_cu);
    }
    if (grid < 0) return;
    Args a{};
    for (int i = 0; i < 25; ++i) a.in[i] = (const float*)d_in[i];
    a.out = (float*)d_out; a.ws = (unsigned char*)d_ws;
#if N_LAUNCH_MODE == 1
    a.ph_lo = 0; a.ph_hi = NPHASE;
    void* args[] = {&a};
    hipError_t e = hipLaunchCooperativeKernel((const void*)fwd_kernel, dim3(grid), dim3(512), args, LDS_BYTES, stream);
    if (e != hipSuccess) fprintf(stderr, "cooperative launch failed: %s (grid %d)\n", hipGetErrorString(e), grid);
#else
    for (int ph = 0; ph < NPHASE; ++ph) { a.ph_lo = ph; a.ph_hi = ph + 1; hipLaunchKernelGGL(fwd_kernel, dim3(grid), dim3(512), LDS_BYTES, stream, a); }
#endif
}
```

```cpp
#include <hip/hip_runtime.h>
#include <hip/hip_cooperative_groups.h>
#include <cstdio>
#include <cstdint>
namespace cg = cooperative_groups;

namespace pg8 {
#define PG8_LAS __attribute__((address_space(3)))
typedef unsigned short bf16_t;
typedef short bf16x8 __attribute__((ext_vector_type(8)));
typedef float f32x4 __attribute__((ext_vector_type(4)));
typedef unsigned u32x4 __attribute__((ext_vector_type(4)));
constexpr int BM = 256, BK = 64, HALF = 128, HTB = HALF * BK * 2  , STAGE_BYTES = 8 * HTB, NXCD = 8, WGM = 8;

__host__ __device__ __forceinline__ int lds_byte(int r, int c) { const int st = (r >> 4) * 2 + (c >> 5), rr = r & 15, cc = c & 31, ob = rr * 64 + cc * 2; return st * 1024 + (ob ^ (((ob >> 9) & 1) << 5)); }
__host__ __device__ __forceinline__ void stage_rc(int b, int& R, int& C) { const int st = b / 1024, sb = b % 1024, swz = sb ^ (((sb >> 9) & 1) << 5); R = (st >> 1) * 16 + swz / 64; C = (st & 1) * 32 + (swz % 64) / 2; }
__host__ __device__ __forceinline__ int perm32(int rho) { const int n = rho >> 4, i = rho & 15; return 8 * (i >> 2) + 4 * n + (i & 3); }

struct Unit { int pm, pn; };
struct Gemm { const bf16_t* A; const bf16_t* Bt; int M, N, K; };

struct StaticOrder {
    int nM, nN, nwg, G, c;
    __host__ __device__ void init(int M, int N, int G_, int c_) { nM = M / BM; nN = N / BM; nwg = nM * nN; G = G_; c = c_; }
    __host__ __device__ bool next(int i, Unit& u) const {
        const long L = (long)i * G + c; if (L >= nwg) return false;
        int wgid = (int)L; { const int q = nwg / NXCD, r = nwg % NXCD, xcd = wgid % NXCD, off = wgid / NXCD; wgid = (xcd < r ? xcd * (q + 1) : r * (q + 1) + (xcd - r) * q) + off; }
        const int nig = WGM * nN, gid = wgid / nig, fm = gid * WGM, gsz = (nM - fm) < WGM ? (nM - fm) : WGM;
        u.pm = fm + ((wgid % nig) % gsz); u.pn = (wgid % nig) / gsz; return true;
    }
    __device__ __forceinline__ void a_ready(const Unit&) const {}
    __device__ __forceinline__ void done(const Unit&) const {}
};

__device__ __forceinline__ unsigned cvt_pk_bf16(float lo, float hi) { unsigned r; asm volatile("v_cvt_pk_bf16_f32 %0, %1, %2" : "=v"(r) : "v"(lo), "v"(hi)); return r; }

template <class Epi, class Sched, bool ALIGN_EPI = false, bool SP2 = false>
__device__ __forceinline__ void gemm_phase(PG8_LAS unsigned char* lds, const Gemm g, const Sched& S, const Epi& E) {
    const int tid = threadIdx.x, wid = __builtin_amdgcn_readfirstlane(tid >> 6), lane = tid & 63, wr = wid >> 2, wc = wid & 3, fr = lane & 15, fq = lane >> 4;
    const int K = g.K, nt = K / BK;
    unsigned voffA[2], voffB[2];
#pragma unroll
    for (int i = 0; i < 2; ++i) { int R, C; stage_rc(tid * 16 + i * 8192, R, C); const int Rb = Epi::PERM ? ((R & ~31) + perm32(R & 31)) : R;
        voffA[i] = (unsigned)(R * K + C) * 2u; voffB[i] = (unsigned)(Rb * K + C) * 2u; }
    const size_t kstep = (size_t)(BK * 2);
    const size_t hstep = (size_t)HALF * K * 2;
    const size_t tstep = 2 * hstep;
    const unsigned ldsw = (unsigned)wid * 1024u;
    const int aoff = lds_byte(wr * 64 + fr, fq * 8), boff = lds_byte(wc * 32 + fr, fq * 8);
#define PG8_SA(b, h) (((b) * 2 + (h)) * HTB)
#define PG8_SB(b, h) ((4 + (b) * 2 + (h)) * HTB)
#define PG8_STAGE(bufoff, gbase, voff) do { _Pragma("unroll") for (int _i = 0; _i < 2; ++_i) \
        __builtin_amdgcn_global_load_lds((const unsigned*)((const char*)(gbase) + (voff)[_i]), (PG8_LAS unsigned*)(lds + (bufoff) + ldsw + _i * 8192), 16, 0, 0); } while (0)
#define PG8_LDA(dst, b, h) do { _Pragma("unroll") for (int m = 0; m < 4; ++m) _Pragma("unroll") for (int k = 0; k < 2; ++k) dst[m][k] = *(const PG8_LAS bf16x8*)(lds + PG8_SA(b, h) + aoff + m * 2048 + k * 1024); } while (0)
#define PG8_LDB(dst, b, h) do { _Pragma("unroll") for (int n = 0; n < 2; ++n) _Pragma("unroll") for (int k = 0; k < 2; ++k) dst[n][k] = *(const PG8_LAS bf16x8*)(lds + PG8_SB(b, h) + boff + n * 2048 + k * 1024); } while (0)
#define PG8_MMA(ai, bj, At, Bt) do { __builtin_amdgcn_s_setprio(1); _Pragma("unroll") for (int m = 0; m < 4; ++m) _Pragma("unroll") for (int n = 0; n < 2; ++n) _Pragma("unroll") for (int k = 0; k < 2; ++k) \
        acc[ai][bj][m][n] = __builtin_amdgcn_mfma_f32_16x16x32_bf16(Bt[n][k], At[m][k], acc[ai][bj][m][n], 0, 0, 0); __builtin_amdgcn_s_setprio(0); } while (0)
#define PG8_WAIT_V(n) asm volatile("s_waitcnt vmcnt(" #n ")" ::: "memory")
#define PG8_WAIT_L(n) asm volatile("s_waitcnt lgkmcnt(" #n ")" ::: "memory")
#define PG8_BAR __builtin_amdgcn_s_barrier()
#define PG8_SCHED __builtin_amdgcn_sched_barrier(0)
    Unit cur, nxt; int ui = 0;
    if (!S.next(0, cur)) return;
    f32x4 acc[2][2][4][2];
#pragma unroll
    for (int a = 0; a < 2; ++a)
#pragma unroll
        for (int b = 0; b < 2; ++b)
#pragma unroll
            for (int m = 0; m < 4; ++m)
#pragma unroll
                for (int n = 0; n < 2; ++n) acc[a][b][m][n] = (f32x4){0.f, 0.f, 0.f, 0.f};
    bf16x8 At[4][2], B0[2][2], B1[2][2];
    const char* cA = (const char*)g.A + (size_t)cur.pm * tstep; const char* cB = (const char*)g.Bt + (size_t)cur.pn * tstep;
    S.a_ready(cur);
    if constexpr (SP2) {
        PG8_STAGE(PG8_SB(0, 0), cB, voffB); PG8_STAGE(PG8_SB(0, 1), cB + hstep, voffB); PG8_STAGE(PG8_SA(0, 0), cA, voffA); PG8_STAGE(PG8_SA(0, 1), cA + hstep, voffA);
        if (wr == 1) PG8_BAR;
        PG8_WAIT_V(2); PG8_BAR;
        PG8_STAGE(PG8_SB(1, 0), cB + kstep, voffB); PG8_STAGE(PG8_SA(1, 0), cA + kstep, voffA); PG8_STAGE(PG8_SB(1, 1), cB + hstep + kstep, voffB);
        PG8_WAIT_V(6); PG8_BAR;
    } else {
        PG8_STAGE(PG8_SB(0, 0), cB, voffB); PG8_STAGE(PG8_SA(0, 0), cA, voffA); PG8_STAGE(PG8_SB(0, 1), cB + hstep, voffB); PG8_STAGE(PG8_SA(0, 1), cA + hstep, voffA);
        if (wr == 1) PG8_BAR;
        PG8_WAIT_V(4); PG8_BAR;
        PG8_STAGE(PG8_SB(1, 0), cB + kstep, voffB); PG8_STAGE(PG8_SA(1, 0), cA + kstep, voffA); PG8_STAGE(PG8_SB(1, 1), cB + hstep + kstep, voffB);
        PG8_WAIT_V(6); PG8_BAR;
    }
    for (;;) {
        const bool has_next = S.next(ui + 1, nxt);
        const char* nA = has_next ? (const char*)g.A + (size_t)nxt.pm * tstep : cA; const char* nB = has_next ? (const char*)g.Bt + (size_t)nxt.pn * tstep : cB;
        for (int t = 0; t < nt; t += 2) {
            const bool last = (t == nt - 2);
            const char* a1 = cA + (size_t)(t + 1) * kstep;
            const char* a2 = last ? nA : cA + (size_t)(t + 2) * kstep; const char* b2 = last ? nB : cB + (size_t)(t + 2) * kstep;
            const char* a3 = a2 + kstep; const char* b3 = b2 + kstep;
            if (last && has_next) S.a_ready(nxt);
            if constexpr (SP2) {
            PG8_LDB(B0, 0, 0); PG8_LDB(B1, 0, 1); PG8_SCHED; PG8_LDA(At, 0, 0); PG8_STAGE(PG8_SA(1, 1), a1 + hstep, voffA);
            PG8_WAIT_V(8); PG8_WAIT_L(0); PG8_BAR; PG8_MMA(0, 0, At, B0); PG8_MMA(0, 1, At, B1); PG8_BAR; PG8_SCHED;
            PG8_LDA(At, 0, 1); PG8_STAGE(PG8_SB(0, 0), b2, voffB); PG8_STAGE(PG8_SB(0, 1), b2 + hstep, voffB); PG8_STAGE(PG8_SA(0, 0), a2, voffA);
            PG8_WAIT_V(8); PG8_WAIT_L(0); PG8_BAR; PG8_MMA(1, 0, At, B0); PG8_MMA(1, 1, At, B1); PG8_BAR; PG8_SCHED;
            PG8_LDB(B0, 1, 0); PG8_LDB(B1, 1, 1); PG8_SCHED; PG8_LDA(At, 1, 0); PG8_STAGE(PG8_SA(0, 1), a2 + hstep, voffA);
            PG8_WAIT_V(8); PG8_WAIT_L(0); PG8_BAR; PG8_MMA(0, 0, At, B0); PG8_MMA(0, 1, At, B1); PG8_BAR; PG8_SCHED;
            PG8_LDA(At, 1, 1); PG8_STAGE(PG8_SB(1, 0), b3, voffB); PG8_STAGE(PG8_SB(1, 1), b3 + hstep, voffB); PG8_STAGE(PG8_SA(1, 0), a3, voffA);
            PG8_WAIT_V(8); PG8_WAIT_L(0); PG8_BAR; PG8_MMA(1, 0, At, B0); PG8_MMA(1, 1, At, B1); PG8_BAR; PG8_SCHED;
            } else {
            PG8_LDB(B0, 0, 0); PG8_SCHED; PG8_LDA(At, 0, 0); PG8_STAGE(PG8_SA(1, 1), a1 + hstep, voffA);
            PG8_WAIT_L(8); PG8_BAR; PG8_WAIT_L(0); PG8_MMA(0, 0, At, B0); PG8_BAR; PG8_SCHED;
            PG8_LDB(B1, 0, 1); PG8_STAGE(PG8_SB(0, 0), b2, voffB);
            PG8_BAR; PG8_WAIT_L(0); PG8_MMA(0, 1, At, B1); PG8_BAR;
            PG8_LDA(At, 0, 1); PG8_STAGE(PG8_SA(0, 0), a2, voffA);
            PG8_BAR; PG8_WAIT_L(0); PG8_MMA(1, 0, At, B0); PG8_BAR; PG8_SCHED;
            PG8_STAGE(PG8_SB(0, 1), b2 + hstep, voffB);
            PG8_WAIT_V(6); PG8_BAR; PG8_MMA(1, 1, At, B1); PG8_BAR;
            PG8_LDB(B0, 1, 0); PG8_SCHED; PG8_LDA(At, 1, 0); PG8_STAGE(PG8_SA(0, 1), a2 + hstep, voffA);
            PG8_WAIT_L(8); PG8_BAR; PG8_WAIT_L(0); PG8_MMA(0, 0, At, B0); PG8_BAR; PG8_SCHED;
            PG8_LDB(B1, 1, 1); PG8_STAGE(PG8_SB(1, 0), b3, voffB);
            PG8_BAR; PG8_WAIT_L(0); PG8_MMA(0, 1, At, B1); PG8_BAR;
            PG8_LDA(At, 1, 1); PG8_STAGE(PG8_SA(1, 0), a3, voffA);
            PG8_BAR; PG8_WAIT_L(0); PG8_MMA(1, 0, At, B0); PG8_BAR; PG8_SCHED;
            PG8_STAGE(PG8_SB(1, 1), b3 + hstep, voffB);
            PG8_WAIT_V(6); PG8_BAR; PG8_MMA(1, 1, At, B1); PG8_BAR;
            }
        }
        if constexpr (ALIGN_EPI) { if (wr == 0) PG8_BAR; }
        if constexpr (!Epi::AFTER_DRAIN) { E(acc, cur, wr, wc, fr, fq); S.done(cur); }
        if (!has_next) break;
#pragma unroll
        for (int a = 0; a < 2; ++a)
#pragma unroll
            for (int b = 0; b < 2; ++b)
#pragma unroll
                for (int m = 0; m < 4; ++m)
#pragma unroll
                    for (int n = 0; n < 2; ++n) acc[a][b][m][n] = (f32x4){0.f, 0.f, 0.f, 0.f};
        cur = nxt; cA = nA; cB = nB; ++ui;
        if constexpr (ALIGN_EPI) { if (wr == 1) PG8_BAR; }
    }
    PG8_WAIT_V(0);
    if constexpr (!ALIGN_EPI) { if (wr == 0) PG8_BAR; }
    PG8_BAR;
    if constexpr (Epi::AFTER_DRAIN) { E.fused(acc, cur, wr, wc, fr, fq, lds, wid, lane); S.done(cur); }
#undef PG8_SA
#undef PG8_SB
#undef PG8_STAGE
#undef PG8_LDA
#undef PG8_LDB
#undef PG8_MMA
#undef PG8_WAIT_V
#undef PG8_WAIT_L
#undef PG8_BAR
#undef PG8_SCHED
}
}
#define LAS __attribute__((address_space(3)))
typedef unsigned short bf16;
typedef float f32x4 __attribute__((ext_vector_type(4)));
typedef float f32x2 __attribute__((ext_vector_type(2)));
typedef float f32x16 __attribute__((ext_vector_type(16)));
typedef short bf16x8 __attribute__((ext_vector_type(8)));
typedef short s16x4 __attribute__((ext_vector_type(4)));
typedef unsigned u32x4 __attribute__((ext_vector_type(4)));
typedef unsigned u32x2 __attribute__((ext_vector_type(2)));

constexpr int D = 1024, TP = 4096, TS = 8192, T = 12288, FF = 4096, AH = 2048, NCOND = 9, MODW = 6144;
constexpr float EPS = 1e-6f, LOG2E = 1.4426950408889634f;
constexpr size_t MiB = 1u << 20;
constexpr size_t WS_CTL = 0, WS_MOD = 1 * MiB, WS_PART = 2 * MiB;
constexpr size_t WS_WA_IN = 4 * MiB, WS_WA_OUT = 20 * MiB, WS_WB_QKV = 28 * MiB, WS_WB_O = 34 * MiB, WS_WC_IN = 36 * MiB, WS_WC_OUT = 42 * MiB;
constexpr size_t WS_WF1 = 44 * MiB, WS_WF2 = 76 * MiB, WS_CKB = 108 * MiB, WS_CVT = 116 * MiB, WS_H = 124 * MiB, WS_BUF1 = 148 * MiB, WS_BUF2 = 244 * MiB, WS_END = 292 * MiB;
constexpr int LDS_BYTES = 147456;
constexpr int NPHASE = 29;

using pg8::cvt_pk_bf16;
__device__ __forceinline__ float bf2f(unsigned short b) { return __uint_as_float((unsigned)b << 16); }
__device__ __forceinline__ float gelu_tanh(float x) {
    const float t = x * x, w = x * (0.7978845608f + 0.0356774081f * t);
    const float e = __builtin_amdgcn_exp2f(-2.885390082f * w);
    return x * __builtin_amdgcn_rcpf(1.0f + e);
}
__device__ __forceinline__ int cond_of_tile(int pm) { return pm < 16 ? 8 : ((pm - 16) >> 2); }
__device__ __forceinline__ int cond_of_row(int m) { return m < TP ? 8 : ((m - TP) >> 10); }

typedef pg8::f32x4 af4;
#define ACC_T const pg8::f32x4 (&acc)[2][2][4][2]
template <int ACT> struct EpiAct {
    static constexpr bool PERM = true, AFTER_DRAIN = false;
    bf16* O; int ldc;
    __device__ __forceinline__ void operator()(ACC_T, const pg8::Unit& u, int wr, int wc, int fr, int fq) const {
        const int row0 = u.pm * 256 + wr * 64 + fr, col0 = u.pn * 256 + wc * 32 + 8 * fq;
#pragma unroll
        for (int ai = 0; ai < 2; ++ai)
#pragma unroll
            for (int m = 0; m < 4; ++m) { bf16* rowp = O + (size_t)(row0 + ai * 128 + m * 16) * ldc + col0;
#pragma unroll
                for (int bj = 0; bj < 2; ++bj) { af4 v0 = acc[ai][bj][m][0], v1 = acc[ai][bj][m][1];
                    if (ACT == 1) {
#pragma unroll
                        for (int i = 0; i < 4; ++i) { v0[i] = gelu_tanh(v0[i]); v1[i] = gelu_tanh(v1[i]); } }
                    if (ACT == 2) {
#pragma unroll
                        for (int i = 0; i < 4; ++i) { float a = fmaxf(v0[i], 0.f), b = fmaxf(v1[i], 0.f); v0[i] = a * a; v1[i] = b * b; } }
                    u32x4 w; w.x = cvt_pk_bf16(v0[0], v0[1]); w.y = cvt_pk_bf16(v0[2], v0[3]); w.z = cvt_pk_bf16(v1[0], v1[1]); w.w = cvt_pk_bf16(v1[2], v1[3]);
                    *(u32x4*)(rowp + bj * 128) = w; } }
    }
};
struct EpiVT {
    static constexpr bool PERM = true, AFTER_DRAIN = false;
    bf16* O; float* part;
    __device__ __forceinline__ void operator()(ACC_T, const pg8::Unit& u, int wr, int wc, int fr, int fq) const {
        const int row0 = u.pm * 256 + wr * 64 + fr, col0 = u.pn * 256 + wc * 32 + 8 * fq;
        float cs[2][2][4];
#pragma unroll
        for (int bj = 0; bj < 2; ++bj)
#pragma unroll
            for (int n = 0; n < 2; ++n)
#pragma unroll
                for (int i = 0; i < 4; ++i) cs[bj][n][i] = 0.f;
#pragma unroll
        for (int ai = 0; ai < 2; ++ai)
#pragma unroll
            for (int m = 0; m < 4; ++m) { bf16* rowp = O + (size_t)(row0 + ai * 128 + m * 16) * T + col0;
#pragma unroll
                for (int bj = 0; bj < 2; ++bj) { af4 v0 = acc[ai][bj][m][0], v1 = acc[ai][bj][m][1];
#pragma unroll
                    for (int i = 0; i < 4; ++i) { v0[i] = gelu_tanh(v0[i]); v1[i] = gelu_tanh(v1[i]); cs[bj][0][i] += v0[i] * v0[i]; cs[bj][1][i] += v1[i] * v1[i]; }
                    u32x4 w; w.x = cvt_pk_bf16(v0[0], v0[1]); w.y = cvt_pk_bf16(v0[2], v0[3]); w.z = cvt_pk_bf16(v1[0], v1[1]); w.w = cvt_pk_bf16(v1[2], v1[3]);
                    *(u32x4*)(rowp + bj * 128) = w; }
                asm volatile("" : "+v"(cs[0][0][0]), "+v"(cs[0][0][1]), "+v"(cs[0][0][2]), "+v"(cs[0][0][3]), "+v"(cs[0][1][0]), "+v"(cs[0][1][1]), "+v"(cs[0][1][2]), "+v"(cs[0][1][3]),
                             "+v"(cs[1][0][0]), "+v"(cs[1][0][1]), "+v"(cs[1][0][2]), "+v"(cs[1][0][3]), "+v"(cs[1][1][0]), "+v"(cs[1][1][1]), "+v"(cs[1][1][2]), "+v"(cs[1][1][3])); }
#pragma unroll
        for (int bj = 0; bj < 2; ++bj)
#pragma unroll
            for (int n = 0; n < 2; ++n)
#pragma unroll
                for (int i = 0; i < 4; ++i) { float s = cs[bj][n][i]; s += __shfl_xor(s, 1); s += __shfl_xor(s, 2); s += __shfl_xor(s, 4); s += __shfl_xor(s, 8);
                    if (fr == 0) part[(size_t)(col0 + bj * 128 + 4 * n + i) * 16 + u.pm * 2 + wr] = s; }
    }
};
struct EpiRes {
    static constexpr bool PERM = true, AFTER_DRAIN = false;
    float* x; const float* gate;
    __device__ __forceinline__ void operator()(ACC_T, const pg8::Unit& u, int wr, int wc, int fr, int fq) const {
        const int row0 = u.pm * 256 + wr * 64 + fr, col0 = u.pn * 256 + wc * 32 + 8 * fq;
        const float* gp = gate + (size_t)cond_of_tile(u.pm) * MODW + col0;
        f32x4 g[2][2];
#pragma unroll
        for (int bj = 0; bj < 2; ++bj) { g[bj][0] = *(const f32x4*)(gp + bj * 128); g[bj][1] = *(const f32x4*)(gp + bj * 128 + 4); }
#pragma unroll
        for (int ai = 0; ai < 2; ++ai)
#pragma unroll
            for (int m = 0; m < 4; ++m) { float* rowp = x + (size_t)(row0 + ai * 128 + m * 16) * D + col0;
#pragma unroll
                for (int bj = 0; bj < 2; ++bj) { f32x4 x0 = *(const f32x4*)(rowp + bj * 128), x1 = *(const f32x4*)(rowp + bj * 128 + 4);
                    x0 += g[bj][0] * acc[ai][bj][m][0]; x1 += g[bj][1] * acc[ai][bj][m][1];
                    *(f32x4*)(rowp + bj * 128) = x0; *(f32x4*)(rowp + bj * 128 + 4) = x1; } }
    }
};
struct EpiQK {
    static constexpr bool PERM = true, AFTER_DRAIN = false;
    bf16* q; bf16* k; const float* qg; const float* kg; float* nck;
    __device__ __forceinline__ void operator()(ACC_T, const pg8::Unit& u, int wr, int wc, int fr, int fq) const {
        const bool isq = u.pn < 4; const int head = 4 * (u.pn & 3) + wc;
        bf16* dst = isq ? q : k; const float* gn = isq ? qg : kg; const float osc = isq ? 0.125f * LOG2E : 1.0f;
        f32x4 g[2][2];
#pragma unroll
        for (int bj = 0; bj < 2; ++bj) { g[bj][0] = *(const f32x4*)(gn + 32 * bj + 8 * fq); g[bj][1] = *(const f32x4*)(gn + 32 * bj + 8 * fq + 4); }
        const int row0 = u.pm * 256 + wr * 64 + fr, col0 = head * 64 + 8 * fq;
#pragma unroll
        for (int ai = 0; ai < 2; ++ai)
#pragma unroll
            for (int m = 0; m < 4; ++m) { const int row = row0 + ai * 128 + m * 16;
                float ss = 0.f;
#pragma unroll
                for (int bj = 0; bj < 2; ++bj)
#pragma unroll
                    for (int n = 0; n < 2; ++n) { const af4 v = acc[ai][bj][m][n]; ss += (v[0] * v[0] + v[1] * v[1]) + (v[2] * v[2] + v[3] * v[3]); }
                ss += __shfl_xor(ss, 16); ss += __shfl_xor(ss, 32);
                const float rstd = __builtin_amdgcn_rsqf(ss * (1.0f / 64.0f) + EPS);
#pragma unroll
                for (int bj = 0; bj < 2; ++bj) { f32x4 v0 = acc[ai][bj][m][0] * rstd * g[bj][0], v1 = acc[ai][bj][m][1] * rstd * g[bj][1];
                    v0 *= osc; v1 *= osc;
                    u32x4 w; w.x = cvt_pk_bf16(v0[0], v0[1]); w.y = cvt_pk_bf16(v0[2], v0[3]); w.z = cvt_pk_bf16(v1[0], v1[1]); w.w = cvt_pk_bf16(v1[2], v1[3]);
                    *(u32x4*)(dst + (size_t)row * D + col0 + 32 * bj) = w; } }
    }
};
struct EpiVTattn {
    static constexpr bool PERM = true, AFTER_DRAIN = false;
    bf16* O; float* ncv;
    __device__ __forceinline__ void operator()(ACC_T, const pg8::Unit& u, int wr, int wc, int fr, int fq) const {
        const int row0 = u.pm * 256 + wr * 64 + fr, col0 = u.pn * 256 + wc * 32 + 8 * fq;
#pragma unroll
        for (int ai = 0; ai < 2; ++ai)
#pragma unroll
            for (int m = 0; m < 4; ++m) { const int row = row0 + ai * 128 + m * 16; bf16* rowp = O + (size_t)row * T + col0;
#pragma unroll
                for (int bj = 0; bj < 2; ++bj) { const af4 v0 = acc[ai][bj][m][0], v1 = acc[ai][bj][m][1];
                    u32x4 w; w.x = cvt_pk_bf16(v0[0], v0[1]); w.y = cvt_pk_bf16(v0[2], v0[3]); w.z = cvt_pk_bf16(v1[0], v1[1]); w.w = cvt_pk_bf16(v1[2], v1[3]);
                    *(u32x4*)(rowp + bj * 128) = w; } }
    }
};
struct EpiConvIn {
    static constexpr bool PERM = true, AFTER_DRAIN = false;
    bf16* bg; bf16* z;
    __device__ __forceinline__ void operator()(ACC_T, const pg8::Unit& u, int wr, int wc, int fr, int fq) const {
        const int row0 = u.pm * 256 + wr * 64 + fr;
#pragma unroll
        for (int ai = 0; ai < 2; ++ai)
#pragma unroll
            for (int m = 0; m < 4; ++m) { const size_t row = (size_t)(row0 + ai * 128 + m * 16);
                if (u.pn < 4) {
#pragma unroll
                    for (int bj = 0; bj < 2; ++bj) { const af4 v0 = acc[ai][bj][m][0], v1 = acc[ai][bj][m][1];
                        u32x4 w; w.x = cvt_pk_bf16(v0[0], v0[1]); w.y = cvt_pk_bf16(v0[2], v0[3]); w.z = cvt_pk_bf16(v1[0], v1[1]); w.w = cvt_pk_bf16(v1[2], v1[3]);
                        *(u32x4*)(bg + row * D + u.pn * 256 + bj * 128 + wc * 32 + 8 * fq) = w; }
                } else {
                    const af4 v0 = acc[ai][0][m][0] * acc[ai][1][m][0], v1 = acc[ai][0][m][1] * acc[ai][1][m][1];
                    u32x4 w; w.x = cvt_pk_bf16(v0[0], v0[1]); w.y = cvt_pk_bf16(v0[2], v0[3]); w.z = cvt_pk_bf16(v1[0], v1[1]); w.w = cvt_pk_bf16(v1[2], v1[3]);
                    *(u32x4*)(z + row * D + (u.pn - 4) * 128 + wc * 32 + 8 * fq) = w; } }
    }
};
struct Args { const float* in[25]; float* out; unsigned char* ws; int ph_lo, ph_hi; };
enum { I_XP = 0, I_XS, I_CK, I_CV, I_C, I_CCTX, I_NORMG, I_ADAW, I_ADAB, I_AWIN, I_AVG, I_AWS, I_ABS, I_AWOUT, I_BWQKV, I_BQG, I_BKG, I_RPB, I_BWO, I_CWIN, I_CCW, I_CCB, I_CWOUT, I_FW1, I_FW2 };

#define LDS_WAIT() asm volatile("s_waitcnt lgkmcnt(0)" ::: "memory")
__device__ __forceinline__ float wave_sum(float v) {
#pragma unroll
    for (int o = 1; o < 64; o <<= 1) v += __shfl_xor(v, o);
    return v;
}
__device__ __forceinline__ int rowmap(int mode, int n) {
    if (mode == 1) { if (n >= 2048) return n; const int sect = n >> 10, hh = (n & 1023) >> 6, d = n & 63; return 256 * (sect * 4 + (hh >> 2)) + 128 * (d >> 5) + 32 * (hh & 3) + (d & 31); }
    if (mode == 2) { if (n < 1024) return n; const int s = (n >= 2048), ch = n - 1024 - 1024 * s; return 1024 + 256 * (ch >> 7) + 128 * s + (ch & 127); }
    return n;
}
__device__ __forceinline__ void transpose_item(const float* W, int K, int N, bf16* WT, int mode, LAS float* scr, int item, int lane) {
    const int nblk = N / 32, kb = item / nblk, nb = item % nblk, k0 = 64 * kb, n0 = 32 * nb;
#pragma unroll 8
    for (int i = 0; i < 32; ++i) { const int kk = 2 * i + (lane >> 5); scr[kk * 33 + (lane & 31)] = W[(size_t)(k0 + kk) * N + n0 + (lane & 31)]; }
    LDS_WAIT(); asm volatile("" ::: "memory");
    const int c = lane & 7; const int r0 = rowmap(mode, n0);
#pragma unroll
    for (int j = 0; j < 4; ++j) { const int n = (lane >> 3) + 8 * j; const LAS float* s = scr + (8 * c) * 33 + n;
        u32x4 o; o.x = cvt_pk_bf16(s[0 * 33], s[1 * 33]); o.y = cvt_pk_bf16(s[2 * 33], s[3 * 33]); o.z = cvt_pk_bf16(s[4 * 33], s[5 * 33]); o.w = cvt_pk_bf16(s[6 * 33], s[7 * 33]);
        *(u32x4*)(WT + (size_t)(r0 + n) * K + k0 + 8 * c) = o; }
    LDS_WAIT(); asm volatile("" ::: "memory");
}
__device__ __forceinline__ void p0_prologue(const Args& a, LAS unsigned char* lds, int tid, int lane, int wave, int G) {
    unsigned char* ws = a.ws;
    if ((int)blockIdx.x < 192) {
        LAS float* sc = (LAS float*)lds;
        LAS float* red = (LAS float*)(lds + 40960);
        for (int e = tid; e < NCOND * D; e += 512) { const int c = e >> 10, k = e & 1023; const float v = (c < 8) ? a.in[I_C][c * D + k] : a.in[I_CCTX][k]; sc[e] = v * __builtin_amdgcn_rcpf(1.0f + __builtin_amdgcn_exp2f(-LOG2E * v)); }
        __syncthreads();
        const int item = blockIdx.x, l = item / 48, n0 = (item % 48) * 128;
        const float* W = a.in[I_ADAW] + (size_t)l * D * MODW + n0 + 2 * lane;
        float acc0[NCOND], acc1[NCOND];
#pragma unroll
        for (int c = 0; c < NCOND; ++c) { acc0[c] = 0.f; acc1[c] = 0.f; }
        const int kbeg = wave * 128;
#pragma unroll 2
        for (int k = kbeg; k < kbeg + 128; k += 4) {
            const f32x2 w0 = *(const f32x2*)(W + (size_t)k * MODW), w1 = *(const f32x2*)(W + (size_t)(k + 1) * MODW), w2 = *(const f32x2*)(W + (size_t)(k + 2) * MODW), w3 = *(const f32x2*)(W + (size_t)(k + 3) * MODW);
#pragma unroll
            for (int c = 0; c < NCOND; ++c) { const f32x4 s = *(const LAS f32x4*)(sc + c * D + k);
                acc0[c] += s[0] * w0[0] + s[1] * w1[0] + s[2] * w2[0] + s[3] * w3[0]; acc1[c] += s[0] * w0[1] + s[1] * w1[1] + s[2] * w2[1] + s[3] * w3[1]; }
        }
#pragma unroll
        for (int c = 0; c < NCOND; ++c) { *(LAS f32x2*)(red + (wave * NCOND + c) * 128 + 2 * lane) = (f32x2){acc0[c], acc1[c]}; }
        __syncthreads();
        float* mod = (float*)(ws + WS_MOD);
        for (int e = tid; e < NCOND * 128; e += 512) { const int c = e >> 7, n = e & 127; float s = a.in[I_ADAB][l * MODW + n0 + n];
#pragma unroll
            for (int w = 0; w < 8; ++w) s += red[(w * NCOND + c) * 128 + n];
            mod[(size_t)(l * NCOND + c) * MODW + n0 + n] = s; }
        __syncthreads();
    }
    LAS float* scr = (LAS float*)(lds + wave * 16384);
    const int gw = blockIdx.x * 8 + wave, NGW = G * 8;
    constexpr int NIT = 28672;
    for (int it = gw; it < NIT; it += NGW) {
        int r = it;
#define TR(cnt, W, K, N, WT, mode) if (r < (cnt)) { transpose_item((W), (K), (N), (WT), (mode), scr, r, lane); continue; } r -= (cnt);
        TR(2048, a.in[I_AWIN], D, 4096, (bf16*)(ws + WS_WA_IN), 0)
        TR(2048, a.in[I_AWIN] + (size_t)D * 4096, D, 4096, (bf16*)(ws + WS_WA_IN + 8 * MiB), 0)
        TR(1024, a.in[I_AWOUT], AH, D, (bf16*)(ws + WS_WA_OUT), 0)
        TR(1024, a.in[I_AWOUT] + (size_t)AH * D, AH, D, (bf16*)(ws + WS_WA_OUT + 4 * MiB), 0)
        TR(1536, a.in[I_BWQKV], D, 3072, (bf16*)(ws + WS_WB_QKV), 1)
        TR(512, a.in[I_BWO], D, D, (bf16*)(ws + WS_WB_O), 0)
        TR(1536, a.in[I_CWIN], D, 3072, (bf16*)(ws + WS_WC_IN), 2)
        TR(512, a.in[I_CWOUT], D, D, (bf16*)(ws + WS_WC_OUT), 0)
        { const int l = r >> 11; if (l < 4) { transpose_item(a.in[I_FW1] + (size_t)l * D * FF, D, FF, (bf16*)(ws + WS_WF1 + (size_t)l * 8 * MiB), 0, scr, r & 2047, lane); continue; } r -= 8192; }
        { const int l = r >> 11; if (l < 4) { transpose_item(a.in[I_FW2] + (size_t)l * D * FF, FF, D, (bf16*)(ws + WS_WF2 + (size_t)l * 8 * MiB), 0, scr, r & 2047, lane); continue; } r -= 8192; }
        { const int b = r >> 8; transpose_item(a.in[I_CV] + (size_t)b * 512 * D, 512, D, (bf16*)(ws + WS_CVT) + (size_t)b * D * 512, 0, scr, r & 255, lane); }
#undef TR
    }
    { const f32x4* src = (const f32x4*)a.in[I_CK]; u32x4* dst = (u32x4*)(ws + WS_CKB);
      for (int e = blockIdx.x * 512 + tid; e < 8 * 512 * D / 8; e += G * 512) { const f32x4 v0 = src[2 * e], v1 = src[2 * e + 1];
          u32x4 w; w.x = cvt_pk_bf16(v0[0], v0[1]); w.y = cvt_pk_bf16(v0[2], v0[3]); w.z = cvt_pk_bf16(v1[0], v1[1]); w.w = cvt_pk_bf16(v1[2], v1[3]); dst[e] = w; } }
}
__device__ __forceinline__ void norm_phase(const Args& a, int l, int which, bool first, int lane, int wave, int G) {
    const float* g = a.in[I_NORMG] + (size_t)(l * 2 + which) * D;
    const float* mod = (const float*)(a.ws + WS_MOD) + (size_t)l * NCOND * MODW + which * 3 * D;
    bf16* H = (bf16*)(a.ws + WS_H);
    f32x4 gv[4];
#pragma unroll
    for (int j = 0; j < 4; ++j) gv[j] = *((const f32x4*)g + lane + 64 * j);
    for (int m = blockIdx.x * 8 + wave; m < T; m += G * 8) {
        const float* xr = first ? (m < TP ? a.in[I_XP] + (size_t)m * D : a.in[I_XS] + (size_t)(m - TP) * D) : a.out + (size_t)m * D;
        const float* mp = mod + (size_t)cond_of_row(m) * MODW;
        f32x4 v[4]; float s = 0.f;
#pragma unroll
        for (int j = 0; j < 4; ++j) { v[j] = *((const f32x4*)xr + lane + 64 * j); s += (v[j][0] * v[j][0] + v[j][1] * v[j][1]) + (v[j][2] * v[j][2] + v[j][3] * v[j][3]); }
        if (first) {
#pragma unroll
            for (int j = 0; j < 4; ++j) *((f32x4*)(a.out + (size_t)m * D) + lane + 64 * j) = v[j]; }
        const float rstd = __builtin_amdgcn_rsqf(wave_sum(s) * (1.0f / D) + EPS);
        u32x2* o8 = (u32x2*)(H + (size_t)m * D) + lane;
#pragma unroll
        for (int j = 0; j < 4; ++j) { const f32x4 sh = *((const f32x4*)mp + lane + 64 * j), scl = *((const f32x4*)(mp + D) + lane + 64 * j);
            const f32x4 y = (v[j] * rstd * gv[j]) * (scl + 1.0f) + sh;
            u32x2 w; w.x = cvt_pk_bf16(y[0], y[1]); w.y = cvt_pk_bf16(y[2], y[3]); o8[64 * j] = w; }
    }
}
#define MFMA32(a, b, c) __builtin_amdgcn_mfma_f32_32x32x16_bf16((a), (b), (c), 0, 0, 0)
#define MFMA16(a, b, c) __builtin_amdgcn_mfma_f32_16x16x32_bf16((a), (b), (c), 0, 0, 0)
__device__ __forceinline__ void gating_phase(const Args& a, int j, LAS unsigned char* lds, int tid, int lane, int wave, int G) {
    const bf16* U = (const bf16*)(a.ws + WS_BUF1); const bf16* VT = U + (size_t)T * AH; bf16* Aout = (bf16*)(a.ws + WS_BUF2);
    const float* part = (const float*)(a.ws + WS_PART);
    const float* wsm = a.in[I_AWS] + (size_t)j * 8 * 128 * 128; const float* bsm = a.in[I_ABS] + (size_t)j * 8 * 128; const float* gain = a.in[I_AVG] + (size_t)j * AH;
    const int fr = lane & 15, fq = lane >> 4;
    int it = 0;
    for (int unit = blockIdx.x; unit < 768; unit += G, ++it) {
        LAS unsigned char* Al = lds + (it & 1) * 36864;
        LAS float* rq = (LAS float*)(lds + 73728 + (it & 1) * 1024);
        LAS float* bsl = rq + 128;
        const int chunk = unit >> 3, g = unit & 7, t0 = chunk * 128;
        if (tid < 128) { const f32x4* pp = (const f32x4*)(part + (size_t)(t0 + tid) * 16); const f32x4 p0 = pp[0], p1 = pp[1], p2 = pp[2], p3 = pp[3];
            const float s = ((p0[0] + p0[1]) + (p0[2] + p0[3])) + ((p1[0] + p1[1]) + (p1[2] + p1[3])) + ((p2[0] + p2[1]) + (p2[2] + p2[3])) + ((p3[0] + p3[1]) + (p3[2] + p3[3]));
            rq[tid] = __builtin_amdgcn_rsqf(s * (1.0f / AH) + EPS); bsl[tid] = bsm[g * 128 + tid]; }
        const int cb = g * 256 + wave * 32;
        bf16x8 afr[2][4];
#pragma unroll
        for (int n = 0; n < 2; ++n) { const bf16* vp = VT + (size_t)(cb + 8 * (fr >> 2) + 4 * n + (fr & 3)) * T + t0 + 8 * fq;
#pragma unroll
            for (int ks = 0; ks < 4; ++ks) afr[n][ks] = *(const bf16x8*)(vp + 32 * ks); }
        const f32x4 g0 = *(const f32x4*)(gain + cb + 8 * fq), g1 = *(const f32x4*)(gain + cb + 8 * fq + 4);
        __syncthreads();
        { const int p = tid >> 2, q0 = (tid & 3) * 32; const float* src = wsm + ((size_t)g * 128 + p) * 128 + q0;
#pragma unroll
          for (int c = 0; c < 4; ++c) { const f32x4 w0 = *(const f32x4*)(src + 8 * c), w1 = *(const f32x4*)(src + 8 * c + 4); const f32x4 r0 = *(const LAS f32x4*)(rq + q0 + 8 * c), r1 = *(const LAS f32x4*)(rq + q0 + 8 * c + 4);
              u32x4 w; w.x = cvt_pk_bf16(w0[0] * r0[0], w0[1] * r0[1]); w.y = cvt_pk_bf16(w0[2] * r0[2], w0[3] * r0[3]); w.z = cvt_pk_bf16(w1[0] * r1[0], w1[1] * r1[1]); w.w = cvt_pk_bf16(w1[2] * r1[2], w1[3] * r1[3]);
              *(LAS u32x4*)(Al + p * 272 + (q0 + 8 * c) * 2) = w; } }
        __syncthreads();
#pragma unroll 2
        for (int pt = 0; pt < 8; ++pt) { const int p = pt * 16 + fr;
            const size_t off = (size_t)(t0 + p) * AH + cb + 8 * fq;
            const bf16x8 uv = *(const bf16x8*)(U + off);
            pg8::f32x4 acc0 = {0.f, 0.f, 0.f, 0.f}, acc1 = {0.f, 0.f, 0.f, 0.f};
#pragma unroll
            for (int ks = 0; ks < 4; ++ks) { const bf16x8 bfr = *(const LAS bf16x8*)(Al + p * 272 + (32 * ks + 8 * fq) * 2);
                acc0 = MFMA16(afr[0][ks], bfr, acc0); acc1 = MFMA16(afr[1][ks], bfr, acc1); }
            const float bsv = bsl[p];
            float r[8];
#pragma unroll
            for (int i = 0; i < 4; ++i) { r[i] = (acc0[i] * g0[i] + bsv) * bf2f((unsigned short)uv[i]); r[4 + i] = (acc1[i] * g1[i] + bsv) * bf2f((unsigned short)uv[4 + i]); }
            u32x4 w; w.x = cvt_pk_bf16(r[0], r[1]); w.y = cvt_pk_bf16(r[2], r[3]); w.z = cvt_pk_bf16(r[4], r[5]); w.w = cvt_pk_bf16(r[6], r[7]);
            *(u32x4*)(Aout + off) = w; }
    }
}
__device__ __forceinline__ void conv_phase(const Args& a, int j, int tid, int G) {
    const bf16* BG = (const bf16*)(a.ws + WS_BUF1); const bf16* Z = BG + (size_t)T * D; bf16* A2 = (bf16*)(a.ws + WS_BUF2);
    const float* cw = a.in[I_CCW] + (size_t)j * 3 * D; const float* cb = a.in[I_CCB] + (size_t)j * D;
    for (int id = blockIdx.x * 512 + tid; id < (T / 12) * 128; id += G * 512) {
        const int ch = (id & 127) * 8, m0 = (id >> 7) * 12;
        f32x4 w0[2], w1[2], w2[2], bb[2];
#pragma unroll
        for (int q = 0; q < 2; ++q) { w0[q] = *(const f32x4*)(cw + ch + 4 * q); w1[q] = *(const f32x4*)(cw + D + ch + 4 * q); w2[q] = *(const f32x4*)(cw + 2 * D + ch + 4 * q); bb[q] = *(const f32x4*)(cb + ch + 4 * q); }
        const bf16x8 zero = {0, 0, 0, 0, 0, 0, 0, 0};
        bf16x8 zp = zero, zc = *(const bf16x8*)(Z + (size_t)m0 * D + ch);
        { const int tpos = m0 < TP ? (m0 & 255) : ((m0 - TP) & 1023); if (tpos > 0) zp = *(const bf16x8*)(Z + (size_t)(m0 - 1) * D + ch); }
#pragma unroll 4
        for (int i = 0; i < 12; ++i) { const int m = m0 + i;
            const int tpos = m < TP ? (m & 255) : ((m - TP) & 1023), L = m < TP ? 256 : 1024;
            bf16x8 znl = zero; if (m + 1 < T) znl = *(const bf16x8*)(Z + (size_t)(m + 1) * D + ch);
            const bf16x8 zn = (tpos < L - 1) ? znl : zero;
            const bf16x8 bgv = *(const bf16x8*)(BG + (size_t)m * D + ch);
            if (tpos == 0) zp = zero;
            float r[8];
#pragma unroll
            for (int e = 0; e < 8; ++e) { const int q = e >> 2, c = e & 3;
                const float v = bb[q][c] + bf2f((unsigned short)zp[e]) * w0[q][c] + bf2f((unsigned short)zc[e]) * w1[q][c] + bf2f((unsigned short)zn[e]) * w2[q][c];
                r[e] = v * bf2f((unsigned short)bgv[e]); }
            u32x4 w; w.x = cvt_pk_bf16(r[0], r[1]); w.y = cvt_pk_bf16(r[2], r[3]); w.z = cvt_pk_bf16(r[4], r[5]); w.w = cvt_pk_bf16(r[6], r[7]);
            *(u32x4*)(A2 + (size_t)m * D + ch) = w;
            zp = zc; zc = znl; }
    }
}
constexpr int AT_KP = 144, AT_VP = 136, AT_KB = 64 * AT_KP, AT_STAGE = 64 * AT_KP + 64 * AT_VP, AT_BUF0 = 2048;
template <bool LOCAL>
__device__ __forceinline__ void attn_stage(const bf16x8 (&qf)[4], const LAS unsigned char* kl, const LAS unsigned char* vl, f32x16& o0, f32x16& o1, float& mrun, float& lsum,
                                           const LAS float* rp, int cq, int cs, int l31, int hf) {
    f32x16 s0, s1;
#pragma unroll
    for (int i = 0; i < 16; ++i) { s0[i] = 0.f; s1[i] = 0.f; }
    const LAS unsigned char* kp = kl + l31 * AT_KP + hf * 16;
#pragma unroll
    for (int ks = 0; ks < 4; ++ks) { const bf16x8 ka = *(const LAS bf16x8*)(kp + ks * 32), kb = *(const LAS bf16x8*)(kp + 32 * AT_KP + ks * 32);
        s0 = MFMA32(ka, qf[ks], s0); s1 = MFMA32(kb, qf[ks], s1); }
    if (LOCAL) {
#pragma unroll
        for (int tl = 0; tl < 2; ++tl) {
            const int d0 = 32 * tl + 4 * hf - cq + 15, e0 = 32 * tl + 4 * hf - cs;
            float bias[16];
#pragma unroll
            for (int i = 0; i < 16; ++i) { int idx = d0 + 8 * (i >> 2) + (i & 3); idx = idx < 0 ? 0 : (idx > 30 ? 30 : idx); bias[i] = rp[idx]; }
            asm volatile("" : "+v"(bias[0]), "+v"(bias[1]), "+v"(bias[2]), "+v"(bias[3]), "+v"(bias[4]), "+v"(bias[5]), "+v"(bias[6]), "+v"(bias[7]),
                              "+v"(bias[8]), "+v"(bias[9]), "+v"(bias[10]), "+v"(bias[11]), "+v"(bias[12]), "+v"(bias[13]), "+v"(bias[14]), "+v"(bias[15]));
#pragma unroll
            for (int i = 0; i < 16; ++i) { const bool ok = (unsigned)(e0 + 8 * (i >> 2) + (i & 3)) < 16u;
                if (tl == 0) s0[i] = ok ? s0[i] + bias[i] : -INFINITY; else s1[i] = ok ? s1[i] + bias[i] : -INFINITY; }
        }
    }
    float mx = fmaxf(s0[0], s1[0]);
#pragma unroll
    for (int i = 1; i < 16; ++i) mx = fmaxf(mx, fmaxf(s0[i], s1[i]));
    mx = fmaxf(mx, __shfl_xor(mx, 32));
    const float mn = fmaxf(mrun, mx), sc = __builtin_amdgcn_exp2f(mrun - mn); mrun = mn;
    float ps = 0.f;
#pragma unroll
    for (int i = 0; i < 16; ++i) { s0[i] = __builtin_amdgcn_exp2f(s0[i] - mn); s1[i] = __builtin_amdgcn_exp2f(s1[i] - mn); ps += s0[i] + s1[i]; }
    lsum = lsum * sc + ps; o0 *= sc; o1 *= sc;
    bf16x8 pb[4];
    { u32x4 w; w.x = cvt_pk_bf16(s0[0], s0[1]); w.y = cvt_pk_bf16(s0[2], s0[3]); w.z = cvt_pk_bf16(s0[4], s0[5]); w.w = cvt_pk_bf16(s0[6], s0[7]); pb[0] = __builtin_bit_cast(bf16x8, w);
      w.x = cvt_pk_bf16(s0[8], s0[9]); w.y = cvt_pk_bf16(s0[10], s0[11]); w.z = cvt_pk_bf16(s0[12], s0[13]); w.w = cvt_pk_bf16(s0[14], s0[15]); pb[1] = __builtin_bit_cast(bf16x8, w);
      w.x = cvt_pk_bf16(s1[0], s1[1]); w.y = cvt_pk_bf16(s1[2], s1[3]); w.z = cvt_pk_bf16(s1[4], s1[5]); w.w = cvt_pk_bf16(s1[6], s1[7]); pb[2] = __builtin_bit_cast(bf16x8, w);
      w.x = cvt_pk_bf16(s1[8], s1[9]); w.y = cvt_pk_bf16(s1[10], s1[11]); w.z = cvt_pk_bf16(s1[12], s1[13]); w.w = cvt_pk_bf16(s1[14], s1[15]); pb[3] = __builtin_bit_cast(bf16x8, w); }
    const LAS unsigned char* vp = vl + l31 * AT_VP + hf * 8;
#pragma unroll
    for (int c = 0; c < 4; ++c) {
        const s16x4 a0 = *(const LAS s16x4*)(vp + c * 32), a1 = *(const LAS s16x4*)(vp + c * 32 + 16);
        const s16x4 b0 = *(const LAS s16x4*)(vp + 32 * AT_VP + c * 32), b1 = *(const LAS s16x4*)(vp + 32 * AT_VP + c * 32 + 16);
        o0 = MFMA32(__builtin_shufflevector(a0, a1, 0, 1, 2, 3, 4, 5, 6, 7), pb[c], o0);
        o1 = MFMA32(__builtin_shufflevector(b0, b1, 0, 1, 2, 3, 4, 5, 6, 7), pb[c], o1); }
}
__device__ __forceinline__ void attn_phase(const Args& a, LAS unsigned char* lds, int tid, int lane, int wave, int G) {
    const bf16* Q = (const bf16*)(a.ws + WS_BUF1); const bf16* Kb = Q + (size_t)T * D; const bf16* VT = Kb + (size_t)T * D;
    const bf16* CKB = (const bf16*)(a.ws + WS_CKB); const bf16* CVT = (const bf16*)(a.ws + WS_CVT);
    bf16* O = (bf16*)(a.ws + WS_BUF2);
    LAS float* rpl = (LAS float*)lds;
    const int l31 = lane & 31, hf = lane >> 5;
    { float* nck = a.out + (size_t)T * D; float* ncv = nck + (size_t)TP * D;
      for (int e = blockIdx.x * 512 + tid; e < TP * D / 8; e += G * 512) { const bf16x8 v = *((const bf16x8*)Kb + e); f32x4 lo, hi;
#pragma unroll
          for (int i = 0; i < 4; ++i) { lo[i] = bf2f((unsigned short)v[i]); hi[i] = bf2f((unsigned short)v[4 + i]); }
          *((f32x4*)nck + 2 * e) = lo; *((f32x4*)nck + 2 * e + 1) = hi; }
      LAS float* scr = (LAS float*)(lds + 2048 + wave * 8704);
      for (int item = blockIdx.x * 8 + wave; item < 2048; item += G * 8) { const int ch0 = (item >> 6) * 32, tok0 = (item & 63) * 64;
#pragma unroll 4
          for (int i = 0; i < 16; ++i) { const int cr = 2 * i + hf; const unsigned w = *(const unsigned*)(VT + (size_t)(ch0 + cr) * T + tok0 + 2 * l31);
              scr[(2 * l31) * 33 + cr] = __uint_as_float(w << 16); scr[(2 * l31 + 1) * 33 + cr] = __uint_as_float(w & 0xffff0000u); }
          LDS_WAIT(); asm volatile("" ::: "memory");
#pragma unroll 4
          for (int i = 0; i < 32; ++i) { const int tr = 2 * i + hf; ncv[(size_t)(tok0 + tr) * D + ch0 + l31] = scr[tr * 33 + l31]; }
          LDS_WAIT(); asm volatile("" ::: "memory"); } }
    const int srow = tid >> 3, schunk = tid & 7;
    for (int unit = blockIdx.x; unit < 768; unit += G) {
        int qrow, h, ns, b, r = 0, rlo = 0, tb = 0, cq = 0, cs = 0, start = 0;
        const bool nat = unit < 512;
        f32x16 o0, o1;
#pragma unroll
        for (int i = 0; i < 16; ++i) { o0[i] = 0.f; o1[i] = 0.f; }
        float mrun = -1e30f, lsum = 0.f;
        __syncthreads();
        if (nat) {
            b = unit >> 6; h = (unit >> 2) & 15; r = 4 * (unit & 3) + (wave >> 1); const int half = wave & 1;
            if (tid < 465) rpl[tid] = a.in[I_RPB][h * 465 + tid] * LOG2E;
            tb = TP + b * 1024; qrow = tb + r * 64 + 32 * half + l31;
            start = r - 4; start = start < 0 ? 0 : (start > 8 ? 8 : start);
            cq = 32 * half + l31; cs = cq - 8; cs = cs < 0 ? 0 : (cs > 48 ? 48 : cs);
            rlo = 4 * (unit & 3) - 4; rlo = rlo < 0 ? 0 : (rlo > 8 ? 8 : rlo); int rhi = 4 * (unit & 3) + 3 - 4; rhi = (rhi < 0 ? 0 : (rhi > 8 ? 8 : rhi)) + 7;
            ns = 8 + (rhi - rlo + 1);
        } else { b = (unit - 512) >> 4; h = (unit - 512) & 15; qrow = b * 256 + 32 * wave + l31; ns = 4; }
        bf16x8 qf[4];
        { const bf16* qp = Q + (size_t)qrow * D + h * 64 + 8 * hf;
#pragma unroll
          for (int ks = 0; ks < 4; ++ks) qf[ks] = *(const bf16x8*)(qp + 16 * ks); }
        u32x4 kr, vr;
#define AT_ISSUE(st) do { const bf16* ks_; const bf16* vs_; \
            if (!nat) { ks_ = Kb + (size_t)(b * 256 + 64 * (st) + srow) * D + h * 64 + 8 * schunk; vs_ = VT + (size_t)(h * 64 + srow) * T + b * 256 + 64 * (st) + 8 * schunk; } \
            else if ((st) < 8) { ks_ = CKB + (size_t)(b * 512 + 64 * (st) + srow) * D + h * 64 + 8 * schunk; vs_ = CVT + (size_t)(b * D + h * 64 + srow) * 512 + 64 * (st) + 8 * schunk; } \
            else { const int t0_ = tb + (rlo + (st) - 8) * 64; ks_ = Kb + (size_t)(t0_ + srow) * D + h * 64 + 8 * schunk; vs_ = VT + (size_t)(h * 64 + srow) * T + t0_ + 8 * schunk; } \
            kr = *(const u32x4*)ks_; vr = *(const u32x4*)vs_; } while (0)
        AT_ISSUE(0);
        for (int st = 0; st < ns; ++st) {
            LAS unsigned char* buf = lds + AT_BUF0 + (st & 1) * AT_STAGE;
            *(LAS u32x4*)(buf + srow * AT_KP + schunk * 16) = kr;
            *(LAS u32x2*)(buf + AT_KB + srow * AT_VP + schunk * 16) = (u32x2){vr.x, vr.y}; *(LAS u32x2*)(buf + AT_KB + srow * AT_VP + schunk * 16 + 8) = (u32x2){vr.z, vr.w};
            if (st + 1 < ns) AT_ISSUE(st + 1);
            __syncthreads();
            if (!nat || st < 8) attn_stage<false>(qf, buf, buf + AT_KB, o0, o1, mrun, lsum, rpl, 0, 0, l31, hf);
            else { const int rr = rlo + st - 8; if (rr >= start && rr < start + 8) attn_stage<true>(qf, buf, buf + AT_KB, o0, o1, mrun, lsum, rpl + (rr - r + 7) * 31, cq, cs, l31, hf); }
        }
#undef AT_ISSUE
        const float inv = 1.0f / (lsum + __shfl_xor(lsum, 32));
        bf16* op = O + (size_t)qrow * D + h * 64 + 4 * hf;
#pragma unroll
        for (int b4 = 0; b4 < 4; ++b4) {
            u32x2 w; w.x = cvt_pk_bf16(o0[4 * b4] * inv, o0[4 * b4 + 1] * inv); w.y = cvt_pk_bf16(o0[4 * b4 + 2] * inv, o0[4 * b4 + 3] * inv); *(u32x2*)(op + 8 * b4) = w;
            w.x = cvt_pk_bf16(o1[4 * b4] * inv, o1[4 * b4 + 1] * inv); w.y = cvt_pk_bf16(o1[4 * b4 + 2] * inv, o1[4 * b4 + 3] * inv); *(u32x2*)(op + 32 + 8 * b4) = w; }
    }
}
#define XB_TMO      128
#define XB_XCNT(j)  (256  + 64 * (j))
#define XB_XSUB(j)  (1280 + 64 * (j))
#define XB_XGEN(j)  (2304 + 64 * (j))
#define XB_TOP      3328
#define XB_TOPGEN   3392
#define XCD_BAR_WORDS 3456
#define XB_SPIN_CAP (1u << 18)

__device__ __forceinline__ unsigned xb_ld(unsigned* p)              { return __hip_atomic_load(p, __ATOMIC_RELAXED, __HIP_MEMORY_SCOPE_AGENT); }
__device__ __forceinline__ unsigned xb_add(unsigned* p, unsigned v) { return __hip_atomic_fetch_add(p, v, __ATOMIC_RELAXED, __HIP_MEMORY_SCOPE_AGENT); }
__device__ __forceinline__ unsigned xb_xcc_id() { return (unsigned)__builtin_amdgcn_s_getreg((3 << 11) | 20) & 0xFu; }
#define XB_SPIN(cond, bar) do { unsigned _sp = 0; while (cond) { __builtin_amdgcn_s_sleep(1); \
    if ((++_sp & 255u) == 0u) { if (xb_ld(&(bar)[XB_TMO])) break; if (_sp > XB_SPIN_CAP) { atomicAdd(&(bar)[XB_TMO], 1u); break; } } } } while (0)

struct XcdBarrier {
    unsigned* bar; unsigned x;
    volatile LAS unsigned* st;
};

__device__ __forceinline__ XcdBarrier xcd_barrier_post(unsigned* bar, volatile LAS unsigned* st) {
    XcdBarrier b; b.bar = bar; b.x = xb_xcc_id(); b.st = st;
    if (threadIdx.x == 0) (void)xb_add(&bar[XB_XCNT(b.x)], 1u);
    return b;
}
__device__ __forceinline__ void xcd_barrier_complete(unsigned* bar, unsigned x, unsigned& nloc, unsigned& nx) {
    const unsigned G = gridDim.x * gridDim.y * gridDim.z;
    unsigned sum, cnt, mine, sp = 0u;
    for (;;) {
        sum = 0u; cnt = 0u; mine = 0u;
#pragma unroll
        for (unsigned j = 0; j < 16; ++j) { const unsigned c = xb_ld(&bar[XB_XCNT(j)]); sum += c; cnt += (c > 0u) ? 1u : 0u; mine = (j == x) ? c : mine; }
        if (sum == G) break;
        __builtin_amdgcn_s_sleep(1);
        if ((++sp & 255u) == 0u) { if (xb_ld(&bar[XB_TMO])) break; if (sp > XB_SPIN_CAP) { atomicAdd(&bar[XB_TMO], 1u); break; } }
    }
    nloc = mine > 0u ? mine : 1u; nx = cnt > 0u ? cnt : 1u;
}

__device__ __forceinline__ void xcd_barrier(const XcdBarrier& b) {
    asm volatile("s_waitcnt vmcnt(0)" ::: "memory");
    __syncthreads();
    if (threadIdx.x == 0) {
        unsigned* bar = b.bar;
        __builtin_amdgcn_s_waitcnt(0);
        unsigned nloc = b.st[0], nx = b.st[1];
        if (nloc == 0u) { xcd_barrier_complete(bar, b.x, nloc, nx); b.st[0] = nloc; b.st[1] = nx; }
        const unsigned old = xb_add(&bar[XB_XSUB(b.x)], 1u);
        const unsigned gen = old / nloc;
        if (old + 1u == (gen + 1u) * nloc) {
            __builtin_amdgcn_fence(__ATOMIC_RELEASE, "agent");
            asm volatile("s_waitcnt vmcnt(0)" ::: "memory");
            const unsigned og = xb_add(&bar[XB_TOP], 1u);
            const unsigned tg = og / nx;
            if (og + 1u == (tg + 1u) * nx) xb_add(&bar[XB_TOPGEN], 1u);
            else XB_SPIN(xb_ld(&bar[XB_TOPGEN]) == tg, bar);
            __builtin_amdgcn_fence(__ATOMIC_ACQUIRE, "agent");
            xb_add(&bar[XB_XGEN(b.x)], 1u);
            asm volatile("s_waitcnt vmcnt(0)" ::: "memory");
        } else {
            XB_SPIN(xb_ld(&bar[XB_XGEN(b.x)]) == gen, bar);
            __builtin_amdgcn_fence(__ATOMIC_ACQUIRE, "agent");
            asm volatile("s_waitcnt vmcnt(0)" ::: "memory");
        }
    }
    __syncthreads();
}


struct EpiU {
    static constexpr bool PERM = true, AFTER_DRAIN = false;
    int type; int ldc; bf16* b0; bf16* b1; const float* f0; const float* f1; float* o0;
    __device__ __forceinline__ void operator()(ACC_T, const pg8::Unit& u, int wr_, int wc_, int fr_, int fq_) const {
        int wr = wr_, wc = wc_, fr = fr_, fq = fq_; asm volatile("" : "+s"(wr), "+s"(wc), "+v"(fr), "+v"(fq));
        switch (type) {
            case 0: { EpiAct<1> E{b0, ldc}; E(acc, u, wr, wc, fr, fq); } break;
            case 1: { EpiAct<2> E{b0, ldc}; E(acc, u, wr, wc, fr, fq); } break;
            case 2: { EpiVT E{b0, o0}; E(acc, u, wr, wc, fr, fq); } break;
            case 3: { EpiRes E{o0, f0}; E(acc, u, wr, wc, fr, fq); } break;
            case 4: { EpiQK E{b0, b1, f0, f1, o0}; E(acc, u, wr, wc, fr, fq); } break;
            case 5: { EpiVTattn E{b0, o0}; E(acc, u, wr, wc, fr, fq); } break;
            default: { EpiConvIn E{b0, b1}; E(acc, u, wr, wc, fr, fq); } break;
        }
    }
};
#ifndef DUP
#define DUP 0
#endif
#ifndef DUPK
#define DUPK 7
#endif
constexpr size_t WS_SCR = 296 * MiB;
#ifndef EN
#define EN 0xffff
#endif
__global__ void __launch_bounds__(512, 2) fwd_kernel(Args a) {
    extern __shared__ __attribute__((aligned(16))) unsigned char lds_raw[];
    LAS unsigned char* lds = (LAS unsigned char*)lds_raw;
    cg::grid_group grid = cg::this_grid();
    const int G = gridDim.x;
    unsigned char* ws = a.ws;
    if (threadIdx.x < 16) ((LAS unsigned*)(lds + 131072 + 64))[threadIdx.x] = 0u;
    if (blockIdx.x == 0) for (int i = threadIdx.x; i < XCD_BAR_WORDS; i += 512) ((unsigned*)(ws + WS_CTL))[i] = 0u;
    __syncthreads();
    XcdBarrier xb; xb.bar = (unsigned*)(ws + WS_CTL); xb.x = 0; xb.st = (volatile LAS unsigned*)(lds + 131072 + 64);
    for (int ph = a.ph_lo; ph < a.ph_hi; ++ph) {
        const int sdup = ph == 0 ? 0 : 1 + (ph - 1) % 7;
        int nrep = (((DUP >> sdup) & 1) && ((DUPK >> (ph == 0 ? 0 : ((ph - 1) / 7) % 3)) & 1)) ? 2 : 1; asm volatile("" : "+s"(nrep));
#pragma clang loop unroll(disable)
        for (int rep = 0; rep < nrep; ++rep) {
        int tid = threadIdx.x; asm volatile("" : "+v"(tid));
        const int lane = tid & 63, wave = __builtin_amdgcn_readfirstlane(tid >> 6);
        bf16* H = (bf16*)(ws + WS_H); bf16* B1 = (bf16*)(ws + WS_BUF1); bf16* B2 = (bf16*)(ws + WS_BUF2);
        if (ph == 0) { if (EN & 1) p0_prologue(a, lds, tid, lane, wave, G); }
        else {
            const int l = (ph - 1) / 7, s = (ph - 1) % 7, kind = l % 3, j = l / 3;
            const float* modl = (const float*)(ws + WS_MOD) + (size_t)l * NCOND * MODW;
            if (s == 0 || s == 4) { if (EN & 2) norm_phase(a, l, s == 4, ph == 1, lane, wave, G); }
            else if (s == 2) {
                if (kind == 0) { if (EN & 512) gating_phase(a, j, lds, tid, lane, wave, G); }
                else if (kind == 1) { if (EN & 1024) attn_phase(a, lds, tid, lane, wave, G); }
                else { if (EN & 2048) conv_phase(a, j, tid, G); }
            } else if (EN & 4) {
                for (int gi = 0; gi < 2; ++gi) {
                    const bf16* A = H; const bf16* Bt; int M = T, N, K = D, shift = 0; EpiU E{};
                    if (s == 5) { if (gi) break; Bt = (const bf16*)(ws + WS_WF1 + (size_t)l * 8 * MiB); N = FF; E.type = 1; E.b0 = B1; E.ldc = FF; }
                    else if (s == 6) { if (gi) break; A = B1; Bt = (const bf16*)(ws + WS_WF2 + (size_t)l * 8 * MiB); N = D; K = FF; E.type = 3; E.o0 = (nrep == 2 && rep == 0) ? (float*)(ws + WS_SCR) : a.out; E.f0 = modl + 5 * D; }
                    else if (s == 3) { if (gi) break; A = B2; Bt = (const bf16*)(ws + (kind == 0 ? WS_WA_OUT + (size_t)j * 4 * MiB : (kind == 1 ? WS_WB_O : WS_WC_OUT))); N = D; K = kind == 0 ? AH : D; E.type = 3; E.o0 = (nrep == 2 && rep == 0) ? (float*)(ws + WS_SCR) : a.out; E.f0 = modl + 2 * D; }
                    else if (kind == 0) { const bf16* W = (const bf16*)(ws + WS_WA_IN + (size_t)j * 8 * MiB);
                        if (gi == 0) { Bt = W; N = AH; E.type = 0; E.b0 = B1; E.ldc = AH; }
                        else { A = W + (size_t)AH * D; Bt = H; M = AH; N = T; shift = 128; E.type = 2; E.b0 = B1 + (size_t)T * AH; E.o0 = (float*)(ws + WS_PART); } }
                    else if (kind == 1) { const bf16* W = (const bf16*)(ws + WS_WB_QKV);
                        if (gi == 0) { Bt = W; N = 2048; E.type = 4; E.b0 = B1; E.b1 = B1 + (size_t)T * D; E.f0 = a.in[I_BQG] + j * 64; E.f1 = a.in[I_BKG] + j * 64; E.o0 = a.out + (size_t)T * D; }
                        else { A = W + (size_t)2048 * D; Bt = H; M = D; N = T; shift = 128; E.type = 5; E.b0 = B1 + (size_t)2 * T * D; E.o0 = a.out + (size_t)T * D + (size_t)TP * D; } }
                    else { if (gi) break; Bt = (const bf16*)(ws + WS_WC_IN); N = 3072; E.type = 6; E.b0 = B1; E.b1 = B1 + (size_t)T * D; }
                    pg8::Gemm g{A, Bt, M, N, K}; pg8::StaticOrder S; S.init(M, N, G, (int)((blockIdx.x + shift) % G));
                    pg8::gemm_phase<EpiU, pg8::StaticOrder, true, true>(lds, g, S, E);
                }
            }
        }
        }
        if (ph + 1 < a.ph_hi) {
            if (ph == a.ph_lo) { grid.sync(); xb = xcd_barrier_post((unsigned*)(ws + WS_CTL), (volatile LAS unsigned*)(lds + 131072 + 64)); }
            else { xcd_barrier(xb); if (DUP & 256) xcd_barrier(xb); }
        }
    }
}

#ifndef N_LAUNCH_MODE
#define N_LAUNCH_MODE 1
#endif
extern "C" void kernel_launch(void* const* d_in, const int* in_sizes, int n_in, void* d_out, int out_size, void* d_ws, size_t ws_size, hipStream_t stream) {
    static int grid = 0;
    if (grid == 0) {
        if (n_in != 25 || ws_size < WS_END) { fprintf(stderr, "kernel_launch: unexpected n_in %d or ws_size %zu\n", n_in, ws_size); grid = -1; return; }
        int dev = 0, cus = 0, per_cu = 0;
        hipGetDevice(&dev); hipDeviceGetAttribute(&cus, hipDeviceAttributeMultiprocessorCount, dev);
        if (hipFuncSetAttribute((const void*)fwd_kernel, hipFuncAttributeMaxDynamicSharedMemorySize, LDS_BYTES) != hipSuccess) { fprintf(stderr, "kernel_launch: hipFuncSetAttribute failed\n"); grid = -1; return; }
        if (hipOccupancyMaxActiveBlocksPerMultiprocessor(&per_cu, (const void*)fwd_kernel, 512, LDS_BYTES) != hipSuccess || per_cu < 1) { fprintf(stderr, "kernel_launch: occupancy query says %d\n", per_cu); per_cu = 1; }
        (void)hipGetLastError();
        grid = cus * per_cu;
        fprintf(stderr, "kernel_launch: grid %d (cus %d x %d)\n", grid, cus, per_cu);
    }
    if (grid < 0) return;
    Args a{};
    for (int i = 0; i < 25; ++i) a.in[i] = (const float*)d_in[i];
    a.out = (float*)d_out; a.ws = (unsigned char*)d_ws;
#if N_LAUNCH_MODE == 1
    a.ph_lo = 0; a.ph_hi = NPHASE;
    void* args[] = {&a};
    hipError_t e = hipLaunchCooperativeKernel((const void*)fwd_kernel, dim3(grid), dim3(512), args, LDS_BYTES, stream);
    if (e != hipSuccess) fprintf(stderr, "cooperative launch failed: %s (grid %d)\n", hipGetErrorString(e), grid);
#else
    for (int ph = 0; ph < NPHASE; ++ph) { a.ph_lo = ph; a.ph_hi = ph + 1; hipLaunchKernelGGL(fwd_kernel, dim3(grid), dim3(512), LDS_BYTES, stream, a); }
#endif
}
```
